# Optimizing an MI355X kernel written in HIP

```python
import jax, jax.numpy as jnp
from jax import lax
import numpy as np

D_MODEL = 1024
BATCH = 32
SEQ = 2048
DEPTH = 2

N_A_LAYERS = DEPTH // 2
N_B_LAYERS = DEPTH - N_A_LAYERS
A_HEADS = 8
A_KEY_DIM = D_MODEL // A_HEADS
A_VAL_DIM = D_MODEL // A_HEADS
A_F_DIM = A_HEADS * A_KEY_DIM
A_I_DIM = A_HEADS * A_VAL_DIM
A_CHUNK = 32
B_HEADS = 8
B_HEAD_DIM = D_MODEL // B_HEADS
MOBA_BLOCK = 256
MOBA_TOPK = 3
Q_BLOCK = 128
ROPE_THETA = 10000.0
NORM_EPS = 1e-6

kernel_name = "hgrn2_moba_yoco_hybrid"

F32 = jnp.float32


def rms_norm(x, g):
    xf = x.astype(F32)
    y = xf * lax.rsqrt(jnp.mean(xf * xf, axis=-1, keepdims=True) + NORM_EPS)
    return (y * g.astype(F32)).astype(x.dtype)


def modulation(c, w, b):
    m = (jax.nn.silu(c) @ w + b)[:, None, :]
    shift, scale, gate = jnp.split(m, 3, axis=-1)
    return shift, scale, gate


def rope_tables(positions):
    inv = ROPE_THETA ** (-jnp.arange(0, B_HEAD_DIM, 2, dtype=F32) / B_HEAD_DIM)
    ang = positions.astype(F32)[..., None] * inv
    return jnp.cos(ang)[:, :, None, :], jnp.sin(ang)[:, :, None, :]


def apply_rope(x, cos, sin):
    xf = x.astype(F32)
    x1, x2 = jnp.split(xf, 2, axis=-1)
    return jnp.concatenate([x1 * cos - x2 * sin, x2 * cos + x1 * sin], axis=-1).astype(x.dtype)


def hgrn2_mixer(u, w_in, w_out, g_norm, lb):
    bsz, T, _ = u.shape
    n_chunks = T // A_CHUNK
    proj = u @ w_in
    q, f, i, g = jnp.split(proj, [A_F_DIM, 2 * A_F_DIM, 2 * A_F_DIM + A_I_DIM], axis=-1)
    q = jax.nn.silu(q.astype(F32))
    fg = lb + (1.0 - lb) * jax.nn.sigmoid(f.astype(F32))
    k = 1.0 - fg
    logf = jnp.log(fg)

    def heads(t, d):
        return t.reshape(bsz, n_chunks, A_CHUNK, A_HEADS, d).transpose(1, 0, 3, 2, 4)

    qc, kc = heads(q, A_KEY_DIM), heads(k, A_KEY_DIM)
    vc = heads(i.astype(F32), A_VAL_DIM)
    bc = jnp.cumsum(heads(logf, A_KEY_DIM), axis=3)
    causal = jnp.tril(jnp.ones((A_CHUNK, A_CHUNK), dtype=bool))

    def step(S, inp):
        q_, k_, v_, b_ = inp
        diff = b_[:, :, :, None, :] - b_[:, :, None, :, :]
        decay = jnp.exp(jnp.where(causal[:, :, None], diff, -jnp.inf))
        att = jnp.einsum('bhtd,bhtsd,bhsd->bhts', q_, decay, k_)
        o = jnp.einsum('bhts,bhsv->bhtv', att, v_) + jnp.einsum('bhtd,bhdv->bhtv', q_ * jnp.exp(b_), S)
        b_last = b_[:, :, -1, :]
        S = jnp.exp(b_last)[..., None] * S + jnp.einsum(
            'bhsd,bhsv->bhdv', k_ * jnp.exp(b_last[:, :, None, :] - b_), v_)
        return S, o

    S0 = jnp.zeros((bsz, A_HEADS, A_KEY_DIM, A_VAL_DIM), F32)
    _, o = lax.scan(step, S0, (qc, kc, vc, bc))
    o = o.transpose(1, 0, 3, 2, 4).reshape(bsz, T, A_HEADS, A_VAL_DIM)
    o = o * lax.rsqrt(jnp.mean(o * o, axis=-1, keepdims=True) + NORM_EPS) * g_norm.astype(F32)
    o = o * jax.nn.silu(g.astype(F32).reshape(bsz, T, A_HEADS, A_VAL_DIM))
    return o.reshape(bsz, T, A_I_DIM).astype(u.dtype) @ w_out


def shared_kv(h, g, w_kv, cos, sin):
    bsz, T, _ = h.shape
    k, v = jnp.split(rms_norm(h, g) @ w_kv, 2, axis=-1)
    k = apply_rope(k.reshape(bsz, T, B_HEADS, B_HEAD_DIM), cos, sin)
    v = v.reshape(bsz, T, B_HEADS, B_HEAD_DIM)
    n_blocks = -(-T // MOBA_BLOCK)
    pad = n_blocks * MOBA_BLOCK - T
    k = jnp.pad(k, ((0, 0), (0, pad), (0, 0), (0, 0)))
    v = jnp.pad(v, ((0, 0), (0, pad), (0, 0), (0, 0)))
    kb = k.reshape(bsz, n_blocks, MOBA_BLOCK, B_HEADS, B_HEAD_DIM).transpose(0, 3, 1, 2, 4).astype(F32)
    vb = v.reshape(bsz, n_blocks, MOBA_BLOCK, B_HEADS, B_HEAD_DIM).transpose(0, 3, 1, 2, 4).astype(F32)
    kmean = jnp.mean(kb, axis=3)
    return kb, vb, kmean


def moba_mixer(u, w_in, w_out, kb, vb, kmean, cos, sin):
    bsz, T, _ = u.shape
    n_blocks = kb.shape[2]
    n_qblocks = T // Q_BLOCK
    k_past = min(MOBA_TOPK, n_blocks)
    n_slots = k_past + 1
    scale = B_HEAD_DIM ** -0.5
    q, z = jnp.split(u @ w_in, 2, axis=-1)
    q = apply_rope(q.reshape(bsz, T, B_HEADS, B_HEAD_DIM), cos, sin)
    qblocks = q.reshape(bsz, n_qblocks, Q_BLOCK, B_HEADS, B_HEAD_DIM).transpose(1, 0, 3, 2, 4)
    offs = jnp.arange(MOBA_BLOCK)
    is_own = jnp.arange(n_slots) == k_past

    def attend(args):
        qi, qb = args
        qf = qb.astype(F32)
        qpos = qi * Q_BLOCK + jnp.arange(Q_BLOCK)
        j = (qi * Q_BLOCK) // MOBA_BLOCK
        gate = jnp.einsum('bhqd,bhnd->bhqn', qf, kmean)
        gate = jnp.where(jnp.arange(n_blocks) < j, gate, -jnp.inf)
        _, top = lax.top_k(gate, k_past)
        idx = jnp.concatenate([top, jnp.full(top.shape[:-1] + (1,), j, top.dtype)], axis=-1)
        logits_blk = jnp.einsum('bhqd,bhnkd->bhqnk', qf, kb) * scale
        logits = jnp.take_along_axis(logits_blk, idx[..., None], axis=3)
        kpos = idx[..., None] * MOBA_BLOCK + offs
        valid = (kpos <= qpos[:, None, None]) & (is_own[:, None] | (idx < j)[..., None])
        logits = jnp.where(valid, logits, -jnp.inf)
        p = jax.nn.softmax(logits.reshape(logits.shape[:3] + (n_slots * MOBA_BLOCK,)), axis=-1)
        p = p.reshape(logits.shape)
        p_blk = jnp.einsum('bhqsk,bhqsn->bhqnk', p, jax.nn.one_hot(idx, n_blocks, dtype=F32))
        return jnp.einsum('bhqnk,bhnkd->bhqd', p_blk, vb)

    o = lax.map(attend, (jnp.arange(n_qblocks), qblocks))
    o = o.transpose(1, 0, 3, 2, 4).reshape(bsz, T, B_HEADS * B_HEAD_DIM)
    o = o * jax.nn.silu(z.astype(F32))
    return o.astype(u.dtype) @ w_out


def setup_inputs(seed: int = 0) -> dict:
    key = jax.random.key(seed)
    ks = jax.random.split(key, 16)
    D = D_MODEL
    s = D ** -0.5
    nrm = lambda k, shape, sc: jax.random.normal(k, shape, F32) * sc
    x = nrm(ks[0], (BATCH, SEQ, D), 1.0)
    c = nrm(ks[1], (BATCH, D), 1.0)
    positions = (jax.random.randint(ks[2], (BATCH, 1), 0, 1024) + jnp.arange(SEQ)[None, :]).astype(jnp.int32)
    mod_w = nrm(ks[3], (DEPTH, D, 3 * D), 0.5 * s)
    mod_b = nrm(ks[4], (DEPTH, 3 * D), 0.02)
    pre_norm_g = 1.0 + nrm(ks[5], (DEPTH, D), 0.02)
    post_norm_g = 1.0 + nrm(ks[6], (DEPTH, D), 0.02)
    a_w_in = nrm(ks[7], (N_A_LAYERS, D, 2 * A_F_DIM + 2 * A_I_DIM), s)
    a_w_out = nrm(ks[8], (N_A_LAYERS, A_I_DIM, D), A_I_DIM ** -0.5)
    a_out_norm_g = 1.0 + nrm(ks[9], (N_A_LAYERS, A_VAL_DIM), 0.02)
    a_lb_logits = nrm(ks[10], (N_A_LAYERS + 1, A_F_DIM), 0.5)
    kv_norm_g = 1.0 + nrm(ks[11], (D,), 0.02)
    w_kv = nrm(ks[12], (D, 2 * B_HEADS * B_HEAD_DIM), s)
    b_w_in = nrm(ks[13], (N_B_LAYERS, D, 2 * B_HEADS * B_HEAD_DIM), s)
    b_w_out = nrm(ks[14], (N_B_LAYERS, B_HEADS * B_HEAD_DIM, D), (B_HEADS * B_HEAD_DIM) ** -0.5)
    return {"x": x, "c": c, "positions": positions, "mod_w": mod_w, "mod_b": mod_b,
            "pre_norm_g": pre_norm_g, "post_norm_g": post_norm_g, "a_w_in": a_w_in,
            "a_w_out": a_w_out, "a_out_norm_g": a_out_norm_g, "a_lb_logits": a_lb_logits,
            "kv_norm_g": kv_norm_g, "w_kv": w_kv, "b_w_in": b_w_in, "b_w_out": b_w_out}


def reference(x, c, positions, mod_w, mod_b, pre_norm_g, post_norm_g, a_w_in, a_w_out,
              a_out_norm_g, a_lb_logits, kv_norm_g, w_kv, b_w_in, b_w_out):
    cos, sin = rope_tables(positions)
    lbs = jnp.cumsum(jax.nn.softmax(a_lb_logits.astype(F32), axis=0), axis=0)
    h = x
    kb = vb = kmean = None
    for layer in range(DEPTH):
        shift, scale, gate = modulation(c, mod_w[layer], mod_b[layer])
        u = rms_norm(h, pre_norm_g[layer]) * (1.0 + scale) + shift
        if layer < N_A_LAYERS:
            y = hgrn2_mixer(u, a_w_in[layer], a_w_out[layer], a_out_norm_g[layer], lbs[layer])
        else:
            if layer == N_A_LAYERS:
                kb, vb, kmean = shared_kv(h, kv_norm_g, w_kv, cos, sin)
            li = layer - N_A_LAYERS
            y = moba_mixer(u, b_w_in[li], b_w_out[li], kb, vb, kmean, cos, sin)
        h = h + gate * rms_norm(y, post_norm_g[layer])
    return h
```

```cpp
#include <hip/hip_runtime.h>
#include <cstdio>
#include <cstdint>
namespace pg8 {
#define PG8_LAS __attribute__((address_space(3)))
typedef unsigned short bf16_t;
typedef short bf16x8 __attribute__((ext_vector_type(8)));
typedef float f32x4 __attribute__((ext_vector_type(4)));
typedef unsigned u32x4 __attribute__((ext_vector_type(4)));
constexpr int BM = 256, BK = 64, HALF = 128, HTB = HALF * BK * 2  , STAGE_BYTES = 8 * HTB, NXCD = 8, WGM = 8;

__host__ __device__ __forceinline__ int lds_byte(int r, int c) { const int st = (r >> 4) * 2 + (c >> 5), rr = r & 15, cc = c & 31, ob = rr * 64 + cc * 2; return st * 1024 + (ob ^ (((ob >> 9) & 1) << 5)); }
__host__ __device__ __forceinline__ void stage_rc(int b, int& R, int& C) { const int st = b / 1024, sb = b % 1024, swz = sb ^ (((sb >> 9) & 1) << 5); R = (st >> 1) * 16 + swz / 64; C = (st & 1) * 32 + (swz % 64) / 2; }
__host__ __device__ __forceinline__ int perm32(int rho) { const int n = rho >> 4, i = rho & 15; return 8 * (i >> 2) + 4 * n + (i & 3); }

struct Unit { int pm, pn; };
struct Gemm { const bf16_t* A; const bf16_t* Bt; int M, N, K; };

struct StaticOrder {
    int nM, nN, nwg, G, c;
    __host__ __device__ void init(int M, int N, int G_, int c_) { nM = M / BM; nN = N / BM; nwg = nM * nN; G = G_; c = c_; }
    __host__ __device__ bool next(int i, Unit& u) const {
        const long L = (long)i * G + c; if (L >= nwg) return false;
        int wgid = (int)L; { const int q = nwg / NXCD, r = nwg % NXCD, xcd = wgid % NXCD, off = wgid / NXCD; wgid = (xcd < r ? xcd * (q + 1) : r * (q + 1) + (xcd - r) * q) + off; }
        const int nig = WGM * nN, gid = wgid / nig, fm = gid * WGM, gsz = (nM - fm) < WGM ? (nM - fm) : WGM;
        u.pm = fm + ((wgid % nig) % gsz); u.pn = (wgid % nig) / gsz; return true;
    }
    __device__ __forceinline__ void a_ready(const Unit&) const {}
    __device__ __forceinline__ void done(const Unit&) const {}
};

typedef float cvt_f32x2_t __attribute__((ext_vector_type(2))); typedef __bf16 cvt_bf16x2_t __attribute__((ext_vector_type(2)));
__device__ __forceinline__ unsigned cvt_pk_bf16(float lo, float hi) { const cvt_f32x2_t v = {lo, hi}; const cvt_bf16x2_t b = __builtin_convertvector(v, cvt_bf16x2_t); return __builtin_bit_cast(unsigned, b); }
typedef float f32x2 __attribute__((ext_vector_type(2)));
__device__ __forceinline__ f32x2 gelu_pk(f32x2 v) {
    const f32x2 av = __builtin_elementwise_abs(v), d = av * 0.2316418882f + 1.0f;
    f32x2 t; t.x = __builtin_amdgcn_rcpf(d.x); t.y = __builtin_amdgcn_rcpf(d.y);
    f32x2 q = t * 0.5307027145f + (-0.7265760135f); q = q * t + 0.7107068705f; q = q * t + (-0.142248368f); q = q * t + 0.127414796f; q = q * t;
    const f32x2 s = (v * v) * (-0.72134752044f);
    f32x2 e; e.x = __builtin_amdgcn_exp2f(s.x); e.y = __builtin_amdgcn_exp2f(s.y);
    const f32x2 m = v * (q * e), r = v - m;
    f32x2 o; o.x = v.x < 0.f ? m.x : r.x; o.y = v.y < 0.f ? m.y : r.y; return o;
}

template <int ACT  > struct EpiBf16 {
    static constexpr bool PERM = true, AFTER_DRAIN = false; static_assert(ACT == 0 || ACT == 1, "EpiBf16: ACT is 0 (none) or 1 (gelu_pk)");
    bf16_t* O; int ldc; const float* bias; int split_cols; size_t split_stride; float scale0;
    __device__ __forceinline__ void operator()(const f32x4 (&acc)[2][2][4][2], const Unit& u, int wr, int wc, int fr, int fq) const {
        const int row0 = u.pm * BM + wr * 64 + fr; int colt = u.pn * BM; bf16_t* base = O;
        float sc = 1.f; if (split_cols) { const int t = colt / split_cols; base += (size_t)t * split_stride; colt -= t * split_cols; if (t == 0) sc = scale0; }
        const int col0 = colt + wc * 32 + 8 * fq, bcol0 = u.pn * BM + wc * 32 + 8 * fq;
        f32x4 bv[2][2];
#pragma unroll
        for (int bj = 0; bj < 2; ++bj)
#pragma unroll
            for (int n = 0; n < 2; ++n) bv[bj][n] = bias ? *(const f32x4*)(bias + bcol0 + bj * HALF + 4 * n) : (f32x4){0.f, 0.f, 0.f, 0.f};
#pragma unroll
        for (int ai = 0; ai < 2; ++ai)
#pragma unroll
            for (int m = 0; m < 4; ++m) { bf16_t* rowp = base + (size_t)(row0 + ai * HALF + m * 16) * ldc + col0;
#pragma unroll
                for (int bj = 0; bj < 2; ++bj) { f32x4 v0 = acc[ai][bj][m][0] + bv[bj][0], v1 = acc[ai][bj][m][1] + bv[bj][1];
                    if (ACT == 1) { f32x2 a = gelu_pk((f32x2){v0[0], v0[1]}), b = gelu_pk((f32x2){v0[2], v0[3]}), c = gelu_pk((f32x2){v1[0], v1[1]}), d = gelu_pk((f32x2){v1[2], v1[3]});
                        v0 = (f32x4){a.x, a.y, b.x, b.y}; v1 = (f32x4){c.x, c.y, d.x, d.y}; }
                    v0 = v0 * sc; v1 = v1 * sc; u32x4 w; w.x = cvt_pk_bf16(v0[0], v0[1]); w.y = cvt_pk_bf16(v0[2], v0[3]); w.z = cvt_pk_bf16(v1[0], v1[1]); w.w = cvt_pk_bf16(v1[2], v1[3]);
                    *(u32x4*)(rowp + bj * HALF) = w; } }
    }
};

struct PanelOrder {
    int nM, nN, G, c;
    __host__ __device__ void init(int M, int N, int G_, int c_) { nM = M / BM; nN = N / BM; G = G_; c = c_; }
    __host__ __device__ bool next(int i, Unit& u) const { const int pm = c + (i / nN) * G; if (pm >= nM) return false; u.pm = pm; u.pn = i % nN; return true; }
    __device__ __forceinline__ void a_ready(const Unit&) const {}
    __device__ __forceinline__ void done(const Unit&) const {}
};

__device__ __forceinline__ float fast_sigmoid(float x) { return __builtin_amdgcn_rcpf(1.0f + __builtin_amdgcn_exp2f(-1.4426950408889634f * x)); }
__device__ __forceinline__ float fast_silu(float x) { return x * fast_sigmoid(x); }
__device__ __forceinline__ u32x4 pack8(const f32x4& v0, const f32x4& v1) { u32x4 w; w.x = cvt_pk_bf16(v0[0], v0[1]); w.y = cvt_pk_bf16(v0[2], v0[3]); w.z = cvt_pk_bf16(v1[0], v1[1]); w.w = cvt_pk_bf16(v1[2], v1[3]); return w; }
__device__ __forceinline__ f32x4 rope4(const f32x4& x, const f32x4& t) { return (f32x4){x[0] * t[0] - x[1] * t[1], x[1] * t[0] + x[0] * t[1], x[2] * t[2] - x[3] * t[3], x[3] * t[2] + x[2] * t[3]}; }
constexpr int LDC = 1024;
constexpr int HM_ROWS = 2048 + 17;
__device__ __forceinline__ size_t hm_base(int pm, int h) { return ((size_t)((pm >> 3) * 8 + h) * HM_ROWS + (size_t)(pm & 7) * 256) * 128; }

struct EpiL0 {
    static constexpr bool PERM = true, AFTER_DRAIN = false;
    bf16_t* QS; bf16_t* LF; bf16_t* VV; bf16_t* GS; const float* lb;
    __device__ __forceinline__ void operator()(const f32x4 (&acc)[2][2][4][2], const Unit& u, int wr, int wc, int fr, int fq) const {
        const int type = u.pn >> 2;
        bf16_t* base = type == 0 ? QS : (type == 1 ? LF : (type == 2 ? VV : GS));
        const int col0 = (u.pn & 3) * BM + wc * 32 + 8 * fq;
        bf16_t* hb = base + hm_base(u.pm, 2 * (u.pn & 3));
        f32x4 lbv[2][2];
#pragma unroll
        for (int bj = 0; bj < 2; ++bj)
#pragma unroll
            for (int n = 0; n < 2; ++n) lbv[bj][n] = (type == 1) ? *(const f32x4*)(lb + col0 + bj * HALF + 4 * n) : (f32x4){0.f, 0.f, 0.f, 0.f};
#pragma unroll
        for (int ai = 0; ai < 2; ++ai)
#pragma unroll
            for (int m = 0; m < 4; ++m) { bf16_t* rowp = hb + (unsigned)((wr * 64 + fr + ai * HALF + m * 16) * 128 + 32 * wc + 8 * fq);
#pragma unroll
                for (int bj = 0; bj < 2; ++bj) { f32x4 v[2] = {acc[ai][bj][m][0], acc[ai][bj][m][1]};
                    if (type == 0 || type == 3) {
#pragma unroll
                        for (int n = 0; n < 2; ++n)
#pragma unroll
                            for (int e = 0; e < 4; ++e) v[n][e] = fast_silu(v[n][e]);
                    } else if (type == 1) {
#pragma unroll
                        for (int n = 0; n < 2; ++n)
#pragma unroll
                            for (int e = 0; e < 4; ++e) { const float l = lbv[bj][n][e];
                                const float k = (1.0f - l) * __builtin_amdgcn_rcpf(1.0f + __builtin_amdgcn_exp2f(1.4426950408889634f * v[n][e]));
                                v[n][e] = k < 0.5f ? k : k - 1.0f; }
                    }
                    __builtin_nontemporal_store(pack8(v[0], v[1]), (u32x4*)(rowp + (size_t)bj * HM_ROWS * 128)); } }
    }
};

struct EpiKV {
    static constexpr bool PERM = true, AFTER_DRAIN = false;
    bf16_t* KB; bf16_t* VB; const int* pos; const float* tab; float* KM;
    __device__ __forceinline__ void operator()(const f32x4 (&acc)[2][2][4][2], const Unit& u, int wr, int wc, int fr, int fq) const {
        const int type = u.pn >> 2;
        const int row0 = u.pm * BM + wr * 64 + fr, col0 = (u.pn & 3) * BM + wc * 32 + 8 * fq;
        if (type == 1) {
#pragma unroll
            for (int ai = 0; ai < 2; ++ai)
#pragma unroll
                for (int m = 0; m < 4; ++m) { bf16_t* rowp = VB + hm_base(u.pm, 2 * (u.pn & 3)) + (unsigned)((wr * 64 + fr + ai * HALF + m * 16) * 128 + 32 * wc + 8 * fq);
#pragma unroll
                    for (int bj = 0; bj < 2; ++bj) __builtin_nontemporal_store(pack8(acc[ai][bj][m][0], acc[ai][bj][m][1]), (u32x4*)(rowp + (size_t)bj * HM_ROWS * 128)); }
        } else {
            f32x4 cs[2][2];
#pragma unroll
            for (int bj = 0; bj < 2; ++bj)
#pragma unroll
                for (int n = 0; n < 2; ++n) cs[bj][n] = (f32x4){0.f, 0.f, 0.f, 0.f};
#pragma unroll
            for (int ai = 0; ai < 2; ++ai)
#pragma unroll
                for (int m = 0; m < 4; ++m) { const int row = row0 + ai * HALF + m * 16; int p = pos[row]; p = p < 0 ? 0 : (p > 4095 ? 4095 : p);
                    const float* tp = tab + ((size_t)p * 64 + 16 * wc + 4 * fq) * 2; const f32x4 t0 = *(const f32x4*)tp, t1 = *(const f32x4*)(tp + 4);
                    bf16_t* rowp = KB + hm_base(u.pm, 2 * (u.pn & 3)) + (unsigned)((wr * 64 + fr + ai * HALF + m * 16) * 128 + 32 * wc + 8 * fq);
#pragma unroll
                    for (int bj = 0; bj < 2; ++bj) { const f32x4 r0 = rope4(acc[ai][bj][m][0], t0), r1 = rope4(acc[ai][bj][m][1], t1);
                        cs[bj][0] += r0; cs[bj][1] += r1; __builtin_nontemporal_store(pack8(r0, r1), (u32x4*)(rowp + (size_t)bj * HM_ROWS * 128)); } }
#pragma unroll
            for (int bj = 0; bj < 2; ++bj)
#pragma unroll
                for (int n = 0; n < 2; ++n)
#pragma unroll
                    for (int e = 0; e < 4; ++e) { float s = cs[bj][n][e]; s += __shfl_xor(s, 1); s += __shfl_xor(s, 2); s += __shfl_xor(s, 4); s += __shfl_xor(s, 8); cs[bj][n][e] = s; }
            if (fr == 0) { const int b = u.pm >> 3, blk = u.pm & 7;
#pragma unroll
                for (int bj = 0; bj < 2; ++bj) { const int h = 2 * (u.pn & 3) + bj; float* kp = KM + ((size_t)(((b * 8 + h) * 8 + blk) * 2 + wr)) * 128 + 32 * wc + 8 * fq;
                    *(f32x4*)kp = cs[bj][0]; *(f32x4*)(kp + 4) = cs[bj][1]; } }
        }
    }
};

struct EpiQZ {
    static constexpr bool PERM = true, AFTER_DRAIN = false;
    bf16_t* QB; bf16_t* ZS; const int* pos; const float* tab; float qscale;
    __device__ __forceinline__ void operator()(const f32x4 (&acc)[2][2][4][2], const Unit& u, int wr, int wc, int fr, int fq) const {
        const int type = u.pn >> 2;
        const int row0 = u.pm * BM + wr * 64 + fr, col0 = (u.pn & 3) * BM + wc * 32 + 8 * fq;
        if (type == 1) {
#pragma unroll
            for (int ai = 0; ai < 2; ++ai)
#pragma unroll
                for (int m = 0; m < 4; ++m) { bf16_t* rowp = ZS + (size_t)(row0 + ai * HALF + m * 16) * LDC + col0;
#pragma unroll
                    for (int bj = 0; bj < 2; ++bj) { f32x4 v[2] = {acc[ai][bj][m][0], acc[ai][bj][m][1]};
#pragma unroll
                        for (int n = 0; n < 2; ++n)
#pragma unroll
                            for (int e = 0; e < 4; ++e) v[n][e] = fast_silu(v[n][e]);
                        *(u32x4*)(rowp + bj * HALF) = pack8(v[0], v[1]); } }
        } else {
#pragma unroll
            for (int ai = 0; ai < 2; ++ai)
#pragma unroll
                for (int m = 0; m < 4; ++m) { const int row = row0 + ai * HALF + m * 16; int p = pos[row]; p = p < 0 ? 0 : (p > 4095 ? 4095 : p);
                    const float* tp = tab + ((size_t)p * 64 + 16 * wc + 4 * fq) * 2; const f32x4 t0 = *(const f32x4*)tp * qscale, t1 = *(const f32x4*)(tp + 4) * qscale;
                    bf16_t* rowp = QB + (size_t)row * LDC + col0;
#pragma unroll
                    for (int bj = 0; bj < 2; ++bj) *(u32x4*)(rowp + bj * HALF) = pack8(rope4(acc[ai][bj][m][0], t0), rope4(acc[ai][bj][m][1], t1)); }
        }
    }
};
template <class Epi, class Sched, bool ALIGN_EPI = false, bool SP2 = false>
__device__ __forceinline__ void gemm_phase(PG8_LAS unsigned char* lds, const Gemm g, const Sched& S, const Epi& E) {
    int tid_ = threadIdx.x; asm volatile("" : "+v"(tid_));
    const int tid = tid_, wid = __builtin_amdgcn_readfirstlane(tid >> 6), lane = tid & 63, wr = wid >> 2, wc = wid & 3, fr = lane & 15, fq = lane >> 4;
    const int K = g.K, nt = K / BK;
    unsigned voffA[2], voffB[2];
#pragma unroll
    for (int i = 0; i < 2; ++i) { int R, C; stage_rc(tid * 16 + i * 8192, R, C); const int Rb = Epi::PERM ? ((R & ~31) + perm32(R & 31)) : R;
        voffA[i] = (unsigned)(R * K + C) * 2u; voffB[i] = (unsigned)(Rb * K + C) * 2u; }
    const size_t kstep = (size_t)(BK * 2);
    const size_t hstep = (size_t)HALF * K * 2;
    const size_t tstep = 2 * hstep;
    const unsigned ldsw = (unsigned)wid * 1024u;
    const int aoff = lds_byte(wr * 64 + fr, fq * 8), boff = lds_byte(wc * 32 + fr, fq * 8);
#define PG8_SA(b, h) (((b) * 2 + (h)) * HTB)
#define PG8_SB(b, h) ((4 + (b) * 2 + (h)) * HTB)
#define PG8_STAGE(bufoff, gbase, voff) do { _Pragma("unroll") for (int _i = 0; _i < 2; ++_i) \
        __builtin_amdgcn_global_load_lds((const unsigned*)((const char*)(gbase) + (voff)[_i]), (PG8_LAS unsigned*)(lds + (bufoff) + ldsw + _i * 8192), 16, 0, 0); } while (0)
#define PG8_LDA(dst, b, h) do { _Pragma("unroll") for (int m = 0; m < 4; ++m) _Pragma("unroll") for (int k = 0; k < 2; ++k) dst[m][k] = *(const PG8_LAS bf16x8*)(lds + PG8_SA(b, h) + aoff + m * 2048 + k * 1024); } while (0)
#define PG8_LDB(dst, b, h) do { _Pragma("unroll") for (int n = 0; n < 2; ++n) _Pragma("unroll") for (int k = 0; k < 2; ++k) dst[n][k] = *(const PG8_LAS bf16x8*)(lds + PG8_SB(b, h) + boff + n * 2048 + k * 1024); } while (0)
#define PG8_MMA(ai, bj, At, Bt) do { __builtin_amdgcn_s_setprio(1); _Pragma("unroll") for (int m = 0; m < 4; ++m) _Pragma("unroll") for (int n = 0; n < 2; ++n) _Pragma("unroll") for (int k = 0; k < 2; ++k) \
        acc[ai][bj][m][n] = __builtin_amdgcn_mfma_f32_16x16x32_bf16(Bt[n][k], At[m][k], acc[ai][bj][m][n], 0, 0, 0); __builtin_amdgcn_s_setprio(0); } while (0)
#define PG8_WAIT_V(n) asm volatile("s_waitcnt vmcnt(" #n ")" ::: "memory")
#define PG8_WAIT_L(n) asm volatile("s_waitcnt lgkmcnt(" #n ")" ::: "memory")
#define PG8_BAR __builtin_amdgcn_s_barrier()
#define PG8_SCHED __builtin_amdgcn_sched_barrier(0)
    Unit cur, nxt; int ui = 0;
    if (!S.next(0, cur)) return;
    f32x4 acc[2][2][4][2];
#pragma unroll
    for (int a = 0; a < 2; ++a)
#pragma unroll
        for (int b = 0; b < 2; ++b)
#pragma unroll
            for (int m = 0; m < 4; ++m)
#pragma unroll
                for (int n = 0; n < 2; ++n) acc[a][b][m][n] = (f32x4){0.f, 0.f, 0.f, 0.f};
    bf16x8 At[4][2], B0[2][2], B1[2][2];
    const char* cA = (const char*)g.A + (size_t)cur.pm * tstep; const char* cB = (const char*)g.Bt + (size_t)cur.pn * tstep;
    S.a_ready(cur);
    if constexpr (SP2) {
        PG8_STAGE(PG8_SB(0, 0), cB, voffB); PG8_STAGE(PG8_SB(0, 1), cB + hstep, voffB); PG8_STAGE(PG8_SA(0, 0), cA, voffA); PG8_STAGE(PG8_SA(0, 1), cA + hstep, voffA);
        if (wr == 1) PG8_BAR;
        PG8_WAIT_V(2); PG8_BAR;
        PG8_STAGE(PG8_SB(1, 0), cB + kstep, voffB); PG8_STAGE(PG8_SA(1, 0), cA + kstep, voffA); PG8_STAGE(PG8_SB(1, 1), cB + hstep + kstep, voffB);
        PG8_WAIT_V(6); PG8_BAR;
    } else {
        PG8_STAGE(PG8_SB(0, 0), cB, voffB); PG8_STAGE(PG8_SA(0, 0), cA, voffA); PG8_STAGE(PG8_SB(0, 1), cB + hstep, voffB); PG8_STAGE(PG8_SA(0, 1), cA + hstep, voffA);
        if (wr == 1) PG8_BAR;
        PG8_WAIT_V(4); PG8_BAR;
        PG8_STAGE(PG8_SB(1, 0), cB + kstep, voffB); PG8_STAGE(PG8_SA(1, 0), cA + kstep, voffA); PG8_STAGE(PG8_SB(1, 1), cB + hstep + kstep, voffB);
        PG8_WAIT_V(6); PG8_BAR;
    }
    for (;;) {
        const bool has_next = S.next(ui + 1, nxt);
        const char* nA = has_next ? (const char*)g.A + (size_t)nxt.pm * tstep : cA; const char* nB = has_next ? (const char*)g.Bt + (size_t)nxt.pn * tstep : cB;
        for (int t = 0; t < nt; t += 2) {
            const bool last = (t == nt - 2);
            const char* a1 = cA + (size_t)(t + 1) * kstep;
            const char* a2 = last ? nA : cA + (size_t)(t + 2) * kstep; const char* b2 = last ? nB : cB + (size_t)(t + 2) * kstep;
            const char* a3 = a2 + kstep; const char* b3 = b2 + kstep;
            if (last && has_next) S.a_ready(nxt);
            if constexpr (SP2) {
            PG8_LDB(B0, 0, 0); PG8_LDB(B1, 0, 1); PG8_SCHED; PG8_LDA(At, 0, 0); PG8_STAGE(PG8_SA(1, 1), a1 + hstep, voffA);
            PG8_WAIT_V(8); PG8_WAIT_L(0); PG8_BAR; PG8_MMA(0, 0, At, B0); PG8_MMA(0, 1, At, B1); PG8_BAR; PG8_SCHED;
            PG8_LDA(At, 0, 1); PG8_STAGE(PG8_SB(0, 0), b2, voffB); PG8_STAGE(PG8_SB(0, 1), b2 + hstep, voffB); PG8_STAGE(PG8_SA(0, 0), a2, voffA);
            PG8_WAIT_V(8); PG8_WAIT_L(0); PG8_BAR; PG8_MMA(1, 0, At, B0); PG8_MMA(1, 1, At, B1); PG8_BAR; PG8_SCHED;
            PG8_LDB(B0, 1, 0); PG8_LDB(B1, 1, 1); PG8_SCHED; PG8_LDA(At, 1, 0); PG8_STAGE(PG8_SA(0, 1), a2 + hstep, voffA);
            PG8_WAIT_V(8); PG8_WAIT_L(0); PG8_BAR; PG8_MMA(0, 0, At, B0); PG8_MMA(0, 1, At, B1); PG8_BAR; PG8_SCHED;
            PG8_LDA(At, 1, 1); PG8_STAGE(PG8_SB(1, 0), b3, voffB); PG8_STAGE(PG8_SB(1, 1), b3 + hstep, voffB); PG8_STAGE(PG8_SA(1, 0), a3, voffA);
            PG8_WAIT_V(8); PG8_WAIT_L(0); PG8_BAR; PG8_MMA(1, 0, At, B0); PG8_MMA(1, 1, At, B1); PG8_BAR; PG8_SCHED;
            } else {
            PG8_LDB(B0, 0, 0); PG8_SCHED; PG8_LDA(At, 0, 0); PG8_STAGE(PG8_SA(1, 1), a1 + hstep, voffA);
            PG8_WAIT_L(8); PG8_BAR; PG8_WAIT_L(0); PG8_MMA(0, 0, At, B0); PG8_BAR; PG8_SCHED;
            PG8_LDB(B1, 0, 1); PG8_STAGE(PG8_SB(0, 0), b2, voffB);
            PG8_BAR; PG8_WAIT_L(0); PG8_MMA(0, 1, At, B1); PG8_BAR;
            PG8_LDA(At, 0, 1); PG8_STAGE(PG8_SA(0, 0), a2, voffA);
            PG8_BAR; PG8_WAIT_L(0); PG8_MMA(1, 0, At, B0); PG8_BAR; PG8_SCHED;
            PG8_STAGE(PG8_SB(0, 1), b2 + hstep, voffB);
            PG8_WAIT_V(6); PG8_BAR; PG8_MMA(1, 1, At, B1); PG8_BAR;
            PG8_LDB(B0, 1, 0); PG8_SCHED; PG8_LDA(At, 1, 0); PG8_STAGE(PG8_SA(0, 1), a2 + hstep, voffA);
            PG8_WAIT_L(8); PG8_BAR; PG8_WAIT_L(0); PG8_MMA(0, 0, At, B0); PG8_BAR; PG8_SCHED;
            PG8_LDB(B1, 1, 1); PG8_STAGE(PG8_SB(1, 0), b3, voffB);
            PG8_BAR; PG8_WAIT_L(0); PG8_MMA(0, 1, At, B1); PG8_BAR;
            PG8_LDA(At, 1, 1); PG8_STAGE(PG8_SA(1, 0), a3, voffA);
            PG8_BAR; PG8_WAIT_L(0); PG8_MMA(1, 0, At, B0); PG8_BAR; PG8_SCHED;
            PG8_STAGE(PG8_SB(1, 1), b3 + hstep, voffB);
            PG8_WAIT_V(6); PG8_BAR; PG8_MMA(1, 1, At, B1); PG8_BAR;
            }
        }
        if constexpr (ALIGN_EPI) { if (wr == 0) PG8_BAR; }
        if constexpr (!Epi::AFTER_DRAIN) { E(acc, cur, wr, wc, fr, fq); S.done(cur); }
        if (!has_next) break;
#pragma unroll
        for (int a = 0; a < 2; ++a)
#pragma unroll
            for (int b = 0; b < 2; ++b)
#pragma unroll
                for (int m = 0; m < 4; ++m)
#pragma unroll
                    for (int n = 0; n < 2; ++n) acc[a][b][m][n] = (f32x4){0.f, 0.f, 0.f, 0.f};
        cur = nxt; cA = nA; cB = nB; ++ui;
        if constexpr (ALIGN_EPI) { if (wr == 1) PG8_BAR; }
    }
    PG8_WAIT_V(0);
    if constexpr (!ALIGN_EPI) { if (wr == 0) PG8_BAR; }
    PG8_BAR;
    if constexpr (Epi::AFTER_DRAIN) { E.fused(acc, cur, wr, wc, fr, fq, lds, wid, lane); S.done(cur); }
#undef PG8_SA
#undef PG8_SB
#undef PG8_STAGE
#undef PG8_LDA
#undef PG8_LDB
#undef PG8_MMA
#undef PG8_WAIT_V
#undef PG8_WAIT_L
#undef PG8_BAR
#undef PG8_SCHED
}
}

constexpr int NWAVES = 8;
constexpr int BATCH = 32, SEQ = 2048, DM = 1024, M = BATCH * SEQ;
constexpr int NH = 8, HD = 128;
constexpr float NORM_EPS = 1e-6f;
constexpr float LOG2E = 1.4426950408889634f;
constexpr float QSCALE = 0.08838834764831845f * 1.4426950408889634f;
constexpr int NPH = 10;
#ifndef MK_N_LAUNCHES
#define MK_N_LAUNCHES 1
#endif
constexpr int N_LAUNCHES = MK_N_LAUNCHES;

constexpr size_t MiB = 1u << 20;
constexpr size_t WS_CTL = 0, CTL_ZERO_BYTES = 32768;
constexpr size_t WS_WIN0 = 2 * MiB, WS_WOUT0 = 10 * MiB, WS_WKV = 12 * MiB, WS_WIN1 = 16 * MiB, WS_WOUT1 = 20 * MiB;
constexpr size_t WS_MOD = 22 * MiB;
constexpr size_t WS_LB = 23 * MiB;
constexpr size_t WS_TAB = 24 * MiB;
constexpr size_t WS_KM = 26 * MiB;
constexpr size_t WS_ACT = 32 * MiB, SLOT = 130 * MiB;
constexpr size_t WS_S0 = WS_ACT, WS_S1 = WS_ACT + SLOT, WS_S2 = WS_ACT + 2 * SLOT, WS_S3 = WS_ACT + 3 * SLOT, WS_S4 = WS_ACT + 4 * SLOT, WS_S5 = WS_ACT + 5 * SLOT, WS_S6 = WS_ACT + 6 * SLOT;
constexpr size_t WS_END = WS_ACT + 7 * SLOT;
constexpr int CW_BAR = 4096;

constexpr int RING_BYTES = 131072;
constexpr int LDSCTL_OFF = 143360, MISC_OFF = LDSCTL_OFF + 320;
constexpr int LDS_BYTES = 147456;

#define GAS __attribute__((address_space(1)))
#define LAS __attribute__((address_space(3)))
typedef unsigned short bf16;
typedef unsigned u32x4 __attribute__((ext_vector_type(4)));
typedef unsigned u32x2 __attribute__((ext_vector_type(2)));
typedef float f32x4 __attribute__((ext_vector_type(4)));
typedef float f32x2 __attribute__((ext_vector_type(2)));
typedef short bf16x8 __attribute__((ext_vector_type(8)));
typedef short s16x4 __attribute__((ext_vector_type(4)));
typedef GAS unsigned gu32;
#define RLX_AGENT __ATOMIC_RELAXED, __HIP_MEMORY_SCOPE_AGENT
#define MFMA16(a, b, c) __builtin_amdgcn_mfma_f32_16x16x32_bf16((a), (b), (c), 0, 0, 0)
__device__ __forceinline__ unsigned pk2(float lo, float hi) { return pg8::cvt_pk_bf16(lo, hi); }
__device__ __forceinline__ float bflo(unsigned w) { return __uint_as_float(w << 16); }
__device__ __forceinline__ float bfhi(unsigned w) { return __uint_as_float(w & 0xffff0000u); }
__device__ __forceinline__ float bf2f(bf16 h) { return __uint_as_float((unsigned)h << 16); }
__device__ __forceinline__ bf16 f2bf(float f) { return (bf16)(pk2(f, 0.f) & 0xffffu); }
__device__ __forceinline__ float ex2(float x) { return __builtin_amdgcn_exp2f(x); }
template <int CTRL> __device__ __forceinline__ float dppf(float x) { return __builtin_bit_cast(float, __builtin_amdgcn_mov_dpp(__builtin_bit_cast(int, x), CTRL, 0xf, 0xf, true)); }
__device__ __forceinline__ float wave_sum(float v) {
    v += dppf<0xB1>(v); v += dppf<0x4E>(v); v += dppf<0x141>(v); v += dppf<0x140>(v);
    { auto s = __builtin_amdgcn_permlane16_swap(__float_as_uint(v), __float_as_uint(v), false, false); v = __uint_as_float(s[0]) + __uint_as_float(s[1]); }
    { auto t = __builtin_amdgcn_permlane32_swap(__float_as_uint(v), __float_as_uint(v), false, false); v = __uint_as_float(t[0]) + __uint_as_float(t[1]); }
    return v;
}

#define XB_TMO      128
#define XB_XCNT(j)  (256  + 64 * (j))
#define XB_XSUB(j)  (1280 + 64 * (j))
#define XB_XGEN(j)  (2304 + 64 * (j))
#define XB_TOP      3328
#define XB_TOPGEN   3392
#define XCD_BAR_WORDS 3456
#define XB_SPIN_CAP (1u << 18)

__device__ __forceinline__ unsigned xb_ld(unsigned* p)              { return __hip_atomic_load(p, __ATOMIC_RELAXED, __HIP_MEMORY_SCOPE_AGENT); }
__device__ __forceinline__ unsigned xb_add(unsigned* p, unsigned v) { return __hip_atomic_fetch_add(p, v, __ATOMIC_RELAXED, __HIP_MEMORY_SCOPE_AGENT); }
__device__ __forceinline__ unsigned xb_xcc_id() { return (unsigned)__builtin_amdgcn_s_getreg((3 << 11) | 20) & 0xFu; }
#define XB_SPIN(cond, bar) do { unsigned _sp = 0; while (cond) { __builtin_amdgcn_s_sleep(1); \
    if ((++_sp & 255u) == 0u) { if (xb_ld(&(bar)[XB_TMO])) break; if (_sp > XB_SPIN_CAP) { atomicAdd(&(bar)[XB_TMO], 1u); break; } } } } while (0)

struct XcdBarrier { unsigned* bar; unsigned x; volatile LAS unsigned* st; };
__device__ __forceinline__ XcdBarrier xcd_barrier_post(unsigned* bar, volatile LAS unsigned* st) {
    XcdBarrier b; b.bar = bar; b.x = xb_xcc_id(); b.st = st;
    if (threadIdx.x == 0) (void)xb_add(&bar[XB_XCNT(b.x)], 1u);
    return b;
}
__device__ __forceinline__ void xcd_barrier_complete(unsigned* bar, unsigned x, unsigned& nloc, unsigned& nx) {
    const unsigned G = gridDim.x * gridDim.y * gridDim.z;
    unsigned sum, cnt, mine, sp = 0u;
    for (;;) {
        sum = 0u; cnt = 0u; mine = 0u;
#pragma unroll
        for (unsigned j = 0; j < 16; ++j) { const unsigned c = xb_ld(&bar[XB_XCNT(j)]); sum += c; cnt += (c > 0u) ? 1u : 0u; mine = (j == x) ? c : mine; }
        if (sum == G) break;
        __builtin_amdgcn_s_sleep(1);
        if ((++sp & 255u) == 0u) { if (xb_ld(&bar[XB_TMO])) break; if (sp > XB_SPIN_CAP) { atomicAdd(&bar[XB_TMO], 1u); break; } }
    }
    nloc = mine > 0u ? mine : 1u; nx = cnt > 0u ? cnt : 1u;
}
__device__ __forceinline__ void xcd_barrier(const XcdBarrier& b) {
    asm volatile("s_waitcnt vmcnt(0)" ::: "memory");
    __syncthreads();
    if (threadIdx.x == 0) {
        unsigned* bar = b.bar;
        __builtin_amdgcn_s_waitcnt(0);
        unsigned nloc = b.st[0], nx = b.st[1];
        if (nloc == 0u) { xcd_barrier_complete(bar, b.x, nloc, nx); b.st[0] = nloc; b.st[1] = nx; }
        const unsigned old = xb_add(&bar[XB_XSUB(b.x)], 1u);
        const unsigned gen = old / nloc;
        if (old + 1u == (gen + 1u) * nloc) {
            __builtin_amdgcn_fence(__ATOMIC_RELEASE, "agent");
            asm volatile("s_waitcnt vmcnt(0)" ::: "memory");
            const unsigned og = xb_add(&bar[XB_TOP], 1u);
            const unsigned tg = og / nx;
            if (og + 1u == (tg + 1u) * nx) xb_add(&bar[XB_TOPGEN], 1u);
            else XB_SPIN(xb_ld(&bar[XB_TOPGEN]) == tg, bar);
            __builtin_amdgcn_fence(__ATOMIC_ACQUIRE, "agent");
            xb_add(&bar[XB_XGEN(b.x)], 1u);
            asm volatile("s_waitcnt vmcnt(0)" ::: "memory");
        } else {
            XB_SPIN(xb_ld(&bar[XB_XGEN(b.x)]) == gen, bar);
            __builtin_amdgcn_fence(__ATOMIC_ACQUIRE, "agent");
            asm volatile("s_waitcnt vmcnt(0)" ::: "memory");
        }
    }
    __syncthreads();
}

struct Frame {
    LAS unsigned char* lds;
    int tid, lane, wave;
    int vcu, G;
    const float *x, *c, *mod_w, *mod_b, *pre_g, *post_g, *a_w_in, *a_w_out, *a_gn, *a_lb, *kv_g, *w_kv, *b_w_in, *b_w_out;
    const int* pos;
    float* out;
    bf16 *Win0, *Wout0, *Wkv, *Win1, *Wout1;
    float *MOD, *LB, *TAB, *KM;
    bf16 *S0, *S1, *S2, *S3, *S4, *S5, *S6;
};

__device__ __forceinline__ int rope_row(int n) { const int h = n >> 7, d = n & 127; return (h << 7) + ((d & 63) << 1) + (d >> 6); }
__device__ __forceinline__ void p0_transpose_item(const float* W, int K, int N, bf16* WT, int perm_cols, LAS float* scr, int item, int lane) {
    const int nblk = N / 32, kb = item / nblk, nb = item % nblk, k0 = 64 * kb, n0 = 32 * nb;
#pragma unroll 8
    for (int i = 0; i < 32; ++i) { const int kk = 2 * i + (lane >> 5); scr[kk * 33 + (lane & 31)] = W[(size_t)(k0 + kk) * N + n0 + (lane & 31)]; }
    asm volatile("s_waitcnt lgkmcnt(0)" ::: "memory");
    const int c = lane & 7;
#pragma unroll
    for (int j = 0; j < 4; ++j) { const int n = (lane >> 3) + 8 * j; const LAS float* s = scr + (8 * c) * 33 + n;
        u32x4 o; o.x = pk2(s[0 * 33], s[1 * 33]); o.y = pk2(s[2 * 33], s[3 * 33]); o.z = pk2(s[4 * 33], s[5 * 33]); o.w = pk2(s[6 * 33], s[7 * 33]);
        const int nn = n0 + n, dr = nn < perm_cols ? rope_row(nn) : nn;
        *(GAS u32x4*)(WT + (size_t)dr * K + k0 + 8 * c) = o; }
    asm volatile("s_waitcnt lgkmcnt(0)" ::: "memory");
}
__device__ __forceinline__ void rope_cs(int pos, int i, float& co, float& si) {
    double inv = 1.0, bs = 0.8659643233600653;
    for (int e = i; e > 0; e >>= 1) { if (e & 1) inv *= bs; bs *= bs; }
    const float ang = (float)pos * (float)inv;
    const double x = (double)ang, kq = __builtin_rint(x * 0.6366197723675814);
    double r = __builtin_fma(-kq, 1.5707963267948966, x); r = __builtin_fma(-kq, 6.123233995736766e-17, r);
    const double r2 = r * r;
    const double sp = r * (1.0 + r2 * (-1.0 / 6 + r2 * (1.0 / 120 + r2 * (-1.0 / 5040 + r2 * (1.0 / 362880 + r2 * (-1.0 / 39916800 + r2 * (1.0 / 6227020800.0)))))));
    const double cp = 1.0 + r2 * (-0.5 + r2 * (1.0 / 24 + r2 * (-1.0 / 720 + r2 * (1.0 / 40320 + r2 * (-1.0 / 3628800 + r2 * (1.0 / 479001600 + r2 * (-1.0 / 87178291200.0)))))));
    const int q = ((int)kq) & 3;
    const double cc = (q == 0) ? cp : (q == 1) ? -sp : (q == 2) ? -cp : sp;
    const double ss = (q == 0) ? sp : (q == 1) ? cp : (q == 2) ? -sp : -cp;
    co = (float)cc; si = (float)ss;
}
__device__ __forceinline__ void p0_modulation_item(Frame& F, int item) {
    const int l = item / 96, n0 = (item % 96) * 32, tid = F.tid;
    LAS float* sc = (LAS float*)F.lds;
#pragma unroll 1
    for (int base = 0; base < 32768; base += 512 * 16) {
        float v[16];
#pragma unroll
        for (int u = 0; u < 16; ++u) v[u] = F.c[base + u * 512 + tid];
#pragma unroll
        for (int u = 0; u < 16; ++u) { const int idx = base + u * 512 + tid, b = idx >> 10, k = idx & 1023; sc[k * 32 + b] = v[u] / (1.0f + __expf(-v[u])); }
    }
    __syncthreads();
    const int col = tid & 31, ks = tid >> 5;
    float acc[32];
#pragma unroll
    for (int b = 0; b < 32; ++b) acc[b] = 0.f;
    const float* w = F.mod_w + (size_t)l * 1024 * 3072 + n0 + col;
#pragma unroll 1
    for (int i0 = 0; i0 < 64; i0 += 16) {
        float wv[16];
#pragma unroll
        for (int u = 0; u < 16; ++u) wv[u] = w[(size_t)(ks + 16 * (i0 + u)) * 3072];
#pragma unroll
        for (int u = 0; u < 16; ++u) { const int k = ks + 16 * (i0 + u); const LAS f32x4* s4 = (const LAS f32x4*)(sc + k * 32);
#pragma unroll
            for (int b4 = 0; b4 < 8; ++b4) { const f32x4 sv = s4[b4]; acc[4 * b4 + 0] += sv[0] * wv[u]; acc[4 * b4 + 1] += sv[1] * wv[u]; acc[4 * b4 + 2] += sv[2] * wv[u]; acc[4 * b4 + 3] += sv[3] * wv[u]; } }
    }
    __syncthreads();
    LAS float* red = sc;
#pragma unroll
    for (int b = 0; b < 32; ++b) red[(ks * 32 + b) * 32 + col] = acc[b];
    __syncthreads();
    for (int o = tid; o < 1024; o += 512) { const int b = o >> 5, cc = o & 31; float s = 0.f;
#pragma unroll
        for (int k2 = 0; k2 < 16; ++k2) s += red[(k2 * 32 + b) * 32 + cc];
        F.MOD[(size_t)(l * 32 + b) * 3072 + n0 + cc] = s + F.mod_b[l * 3072 + n0 + cc]; }
    __syncthreads();
}
__device__ __forceinline__ void p0_prologue(Frame& F) {
    for (int it = F.vcu; it < 192; it += F.G) p0_modulation_item(F, it);
    const int gt = F.vcu * 512 + F.tid, NGT = F.G * 512;
    for (int d = gt; d < 1024; d += NGT) F.LB[d] = 1.0f / (1.0f + __expf(F.a_lb[1024 + d] - F.a_lb[d]));
    for (int idx = gt; idx < 4096 * 64; idx += NGT) { float co, si; rope_cs(idx >> 6, idx & 63, co, si); *(f32x2*)(F.TAB + (size_t)idx * 2) = (f32x2){co, si}; }
    LAS float* scr = (LAS float*)(F.lds + F.wave * 16384);
    const int gw = F.vcu * NWAVES + F.wave, NGW = F.G * NWAVES;
    constexpr int I_IN0 = 16 * 128, I_OUT = 16 * 32, I_KV = 16 * 64;
    constexpr int NITEMS = I_IN0 + 2 * I_OUT + 2 * I_KV;
    for (int it = gw; it < NITEMS; it += NGW) {
        int r = it;
        if (r < I_IN0) { p0_transpose_item(F.a_w_in, 1024, 4096, F.Win0, 0, scr, r, F.lane); continue; } r -= I_IN0;
        if (r < I_OUT) { p0_transpose_item(F.a_w_out, 1024, 1024, F.Wout0, 0, scr, r, F.lane); continue; } r -= I_OUT;
        if (r < I_KV) { p0_transpose_item(F.w_kv, 1024, 2048, F.Wkv, 1024, scr, r, F.lane); continue; } r -= I_KV;
        if (r < I_KV) { p0_transpose_item(F.b_w_in, 1024, 2048, F.Win1, 1024, scr, r, F.lane); continue; } r -= I_KV;
        p0_transpose_item(F.b_w_out, 1024, 1024, F.Wout1, 0, scr, r, F.lane);
    }
}

constexpr int RS = 1;
__device__ __forceinline__ void p1_modnorm(Frame& F) {
    const int gw = F.vcu * NWAVES + F.wave, NGW = F.G * NWAVES, lane = F.lane;
    const int nit = (M - gw + NGW - 1) / NGW;
    f32x4 G[4];
#pragma unroll
    for (int j = 0; j < 4; ++j) G[j] = *(const f32x4*)(F.pre_g + 4 * lane + 256 * j);
    f32x4 xr[4][4], sc[4], sh[4], scn[4], shn[4];
#define P1_ROW(it_) ((size_t)(nit - 1 - (it_)) * NGW + gw)
#define P1_XLOAD(slot, it_) do { const GAS f32x4* xp_ = (const GAS f32x4*)(F.x + P1_ROW(it_) * DM) + lane; _Pragma("unroll") for (int j = 0; j < 4; ++j) xr[slot][j] = __builtin_nontemporal_load(xp_ + 64 * j); } while (0)
#define P1_CLOAD(SC, SH, it_) do { const float* mod_ = F.MOD + (size_t)(P1_ROW(it_) / SEQ) * 3072 + 4 * lane; _Pragma("unroll") for (int j = 0; j < 4; ++j) { SC[j] = *(const f32x4*)(mod_ + 1024 + 256 * j); SH[j] = *(const f32x4*)(mod_ + 256 * j); } } while (0)
#define P1_STEP(slot, it_) do { if ((it_) < nit) { \
        if ((it_) + 1 < nit) P1_CLOAD(scn, shn, (it_) + 1); \
        float ss = 0.f; _Pragma("unroll") for (int j = 0; j < 4; ++j) { const f32x4 v = xr[slot][j]; ss += (v[0] * v[0] + v[1] * v[1]) + (v[2] * v[2] + v[3] * v[3]); } \
        const float rstd = 1.0f / sqrtf(wave_sum(ss) * (1.0f / DM) + NORM_EPS); \
        GAS u32x2* o8 = (GAS u32x2*)(F.S0 + P1_ROW(it_) * DM) + lane; \
        _Pragma("unroll") for (int j = 0; j < 4; ++j) { const f32x4 u = xr[slot][j] * rstd * (G[j] * (1.0f + sc[j])) + sh[j]; o8[64 * j] = (u32x2){pk2(u[0], u[1]), pk2(u[2], u[3])}; } \
        if ((it_) + 4 < nit) P1_XLOAD(slot, (it_) + 4); \
        _Pragma("unroll") for (int j = 0; j < 4; ++j) { sc[j] = scn[j]; sh[j] = shn[j]; } } } while (0)
    if (nit > 0) { P1_CLOAD(sc, sh, 0); }
#pragma unroll
    for (int q = 0; q < 4; ++q) if (q < nit) P1_XLOAD(q, q);
#pragma unroll 1
    for (int it0 = 0; it0 < nit; it0 += 4) { P1_STEP(0, it0); P1_STEP(1, it0 + 1); P1_STEP(2, it0 + 2); P1_STEP(3, it0 + 3); }
#undef P1_XLOAD
#undef P1_ROW
#undef P1_CLOAD
#undef P1_STEP
}
__device__ __forceinline__ void p5_mid(Frame& F) {
    const int gw = F.vcu * NWAVES + F.wave, NGW = F.G * NWAVES, lane = F.lane;
    for (int rb = gw; rb < M / 32; rb += NGW) {
        const int row0 = rb * 32, b = row0 / SEQ;
        const float* mod0 = F.MOD + (size_t)b * 3072; const float* mod1 = F.MOD + (size_t)(32 + b) * 3072;
        f32x4 G0[4], A1[4], B1[4], KG[4];
#pragma unroll
        for (int j = 0; j < 4; ++j) { const int c = 4 * lane + 256 * j;
            G0[j] = *(const f32x4*)(mod0 + 2048 + c) * *(const f32x4*)(F.post_g + c);
            A1[j] = *(const f32x4*)(F.pre_g + 1024 + c) * (1.0f + *(const f32x4*)(mod1 + 1024 + c)); B1[j] = *(const f32x4*)(mod1 + c); KG[j] = *(const f32x4*)(F.kv_g + c); }
        const GAS f32x4* xb = (const GAS f32x4*)(F.x + (size_t)row0 * DM) + lane; const GAS u32x2* yb = (const GAS u32x2*)(F.S6 + (size_t)row0 * DM) + lane;
        f32x4 cx[2][4], nx[2][4]; u32x2 cy[2][4], ny[2][4];
#pragma unroll
        for (int q = 0; q < 2; ++q)
#pragma unroll
            for (int j = 0; j < 4; ++j) { cx[q][j] = __builtin_nontemporal_load(xb + (size_t)(RS * q) * (DM / 4) + 64 * j); cy[q][j] = yb[(size_t)(RS * q) * (DM / 4) + 64 * j]; }
#pragma unroll 1
        for (int r = 0; r < 32; r += 2) {
            if (r + 2 < 32) {
#pragma unroll
                for (int q = 0; q < 2; ++q)
#pragma unroll
                    for (int j = 0; j < 4; ++j) { nx[q][j] = __builtin_nontemporal_load(xb + (size_t)(RS * (r + 2 + q)) * (DM / 4) + 64 * j); ny[q][j] = yb[(size_t)(RS * (r + 2 + q)) * (DM / 4) + 64 * j]; }
            }
#pragma unroll
            for (int q = 0; q < 2; ++q) {
                const size_t ro = (size_t)(row0 + RS * (r + q)) * DM;
                f32x4 v[4], y[4]; float ss = 0.f;
#pragma unroll
                for (int j = 0; j < 4; ++j) { v[j] = cx[q][j]; const u32x2 yw = cy[q][j]; y[j] = (f32x4){bflo(yw.x), bfhi(yw.x), bflo(yw.y), bfhi(yw.y)};
                    ss += (y[j][0] * y[j][0] + y[j][1] * y[j][1]) + (y[j][2] * y[j][2] + y[j][3] * y[j][3]); }
                const float rstd = 1.0f / sqrtf(wave_sum(ss) * (1.0f / DM) + NORM_EPS);
                float s2 = 0.f;
                GAS u32x2* ho = (GAS u32x2*)(F.out + ro) + lane;
#pragma unroll
                for (int j = 0; j < 4; ++j) { v[j] = v[j] + G0[j] * (y[j] * rstd); __builtin_nontemporal_store((u32x2){pk2(v[j][0], v[j][1]), pk2(v[j][2], v[j][3])}, ho + 64 * j); s2 += (v[j][0] * v[j][0] + v[j][1] * v[j][1]) + (v[j][2] * v[j][2] + v[j][3] * v[j][3]); }
                const float rstd1 = 1.0f / sqrtf(wave_sum(s2) * (1.0f / DM) + NORM_EPS);
                GAS u32x2* uo = (GAS u32x2*)(F.S0 + ro) + lane; GAS u32x2* ko = (GAS u32x2*)(F.S1 + ro) + lane;
#pragma unroll
                for (int j = 0; j < 4; ++j) { const f32x4 hn = v[j] * rstd1; const f32x4 u = hn * A1[j] + B1[j], k = hn * KG[j];
                    uo[64 * j] = (u32x2){pk2(u[0], u[1]), pk2(u[2], u[3])}; ko[64 * j] = (u32x2){pk2(k[0], k[1]), pk2(k[2], k[3])}; }
            }
#pragma unroll
            for (int q = 0; q < 2; ++q)
#pragma unroll
                for (int j = 0; j < 4; ++j) { cx[q][j] = nx[q][j]; cy[q][j] = ny[q][j]; }
        }
    }
}
__device__ __forceinline__ void p9_final(Frame& F) {
    const int gw = F.vcu * NWAVES + F.wave, NGW = F.G * NWAVES, lane = F.lane;
    for (int rb = gw; rb < M / 32; rb += NGW) {
        const int row0 = rb * 32, b = row0 / SEQ;
        const float* mod1 = F.MOD + (size_t)(32 + b) * 3072;
        f32x4 G1[4];
#pragma unroll
        for (int j = 0; j < 4; ++j) { const int c = 4 * lane + 256 * j; G1[j] = *(const f32x4*)(mod1 + 2048 + c) * *(const f32x4*)(F.post_g + 1024 + c); }
        GAS f32x4* hb = (GAS f32x4*)(F.out + (size_t)row0 * DM) + lane; const GAS u32x2* yb = (const GAS u32x2*)(F.S0 + (size_t)row0 * DM) + lane;
        const GAS u32x2* hq = (const GAS u32x2*)(F.out + (size_t)row0 * DM) + lane;
        u32x2 ch[2][4], nh[2][4]; u32x2 cy[2][4], ny[2][4];
#pragma unroll
        for (int q = 0; q < 2; ++q)
#pragma unroll
            for (int j = 0; j < 4; ++j) { ch[q][j] = hq[(size_t)(RS * q) * (DM / 2) + 64 * j]; cy[q][j] = yb[(size_t)(RS * q) * (DM / 4) + 64 * j]; }
#pragma unroll 1
        for (int r = 0; r < 32; r += 2) {
            if (r + 2 < 32) {
#pragma unroll
                for (int q = 0; q < 2; ++q)
#pragma unroll
                    for (int j = 0; j < 4; ++j) { nh[q][j] = hq[(size_t)(RS * (r + 2 + q)) * (DM / 2) + 64 * j]; ny[q][j] = yb[(size_t)(RS * (r + 2 + q)) * (DM / 4) + 64 * j]; }
            }
#pragma unroll
            for (int q = 0; q < 2; ++q) {
                f32x4 y[4]; float ss = 0.f;
#pragma unroll
                for (int j = 0; j < 4; ++j) { const u32x2 yw = cy[q][j]; y[j] = (f32x4){bflo(yw.x), bfhi(yw.x), bflo(yw.y), bfhi(yw.y)};
                    ss += (y[j][0] * y[j][0] + y[j][1] * y[j][1]) + (y[j][2] * y[j][2] + y[j][3] * y[j][3]); }
                const float rstd = 1.0f / sqrtf(wave_sum(ss) * (1.0f / DM) + NORM_EPS);
#pragma unroll
                for (int j = 0; j < 4; ++j) { const u32x2 hw = ch[q][j]; const f32x4 hv = (f32x4){bflo(hw.x), bfhi(hw.x), bflo(hw.y), bfhi(hw.y)}; __builtin_nontemporal_store(hv + G1[j] * (y[j] * rstd), hb + (size_t)(RS * (r + q)) * (DM / 4) + 64 * j); }
            }
#pragma unroll
            for (int q = 0; q < 2; ++q)
#pragma unroll
                for (int j = 0; j < 4; ++j) { ch[q][j] = nh[q][j]; cy[q][j] = ny[q][j]; }
        }
    }
}


__device__ __forceinline__ void p3_recurrence3(Frame& F) {
    LAS unsigned char* L = F.lds;
    constexpr int SET = 38400, O_QH = 0, O_KH = 8704, O_KLT = 17408, O_VT = 27648, O_EBL = 37888;
    constexpr int O_ATT = 2 * SET, O_PART = O_ATT + 2560, O_OB = O_PART + 4096;
    const int tid = F.tid, lane = F.lane, w = F.wave, g = lane >> 4, c16 = lane & 15;
    const bf16* QS = F.S1; const bf16* LF = F.S2; const bf16* VV = F.S3; const bf16* GS = F.S4; bf16* O0 = F.S5;
    const f32x4 ZERO4 = (f32x4){0.f, 0.f, 0.f, 0.f};
    const int dp = tid & 63, tq = tid >> 6;
    const int pd = (((2 * dp) & ~31) | ((((2 * dp) >> 2) & 3) << 3) | ((((2 * dp) >> 4) & 1) << 2) | ((2 * dp) & 3)) * 2;
    for (int bh = F.vcu; bh < BATCH * NH; bh += F.G) {
        const int b = bh >> 3, h = bh & 7;
        const size_t rbase = (size_t)b * SEQ;
        f32x4 S[8];
#pragma unroll
        for (int dt = 0; dt < 8; ++dt) S[dt] = ZERO4;
        const size_t hbase = (size_t)bh * pg8::HM_ROWS * HD;
        const bf16* qs_u = QS + hbase; const bf16* lf_u = LF + hbase; const bf16* vv_u = VV + hbase; const bf16* gs_u = GS + hbase; bf16* o0_u = O0 + rbase * DM + h * HD;
        const unsigned lo0 = (unsigned)((4 * tq) * HD + 2 * dp);
        const unsigned go0 = (unsigned)((4 * w + (lane >> 4)) * DM + (lane & 15) * 8);
        const unsigned gi0 = (unsigned)((4 * w + (lane >> 4)) * HD + (lane & 15) * 8);
        const f32x4 gn0 = *(const f32x4*)(F.a_gn + 8 * (lane & 15)), gn1 = *(const f32x4*)(F.a_gn + 8 * (lane & 15) + 4);
        unsigned rq[4], rl[4], rv[4], nq[4], nl[4], nv[4]; u32x4 gsr, gsn = (u32x4){0u, 0u, 0u, 0u};
        float kk0[4], kk1[4], cs0[4], cs1[4];
#define R3_LOAD(c, Q, Lq, V) do { const unsigned cx_ = (unsigned)((c) * 32 * HD) + lo0; _Pragma("unroll") for (int i_ = 0; i_ < 4; ++i_) { \
        Q[i_] = __builtin_nontemporal_load((const GAS unsigned*)(qs_u + (cx_ + i_ * HD))); Lq[i_] = __builtin_nontemporal_load((const GAS unsigned*)(lf_u + (cx_ + i_ * HD))); V[i_] = __builtin_nontemporal_load((const GAS unsigned*)(vv_u + (cx_ + i_ * HD))); } } while (0)
#define R3_ROT() do { _Pragma("unroll") for (int i_ = 0; i_ < 4; ++i_) { rq[i_] = nq[i_]; rl[i_] = nl[i_]; rv[i_] = nv[i_]; } } while (0)
#define R3_WALK() do { float r0_ = 1.f, r1_ = 1.f; _Pragma("unroll") for (int i_ = 0; i_ < 4; ++i_) { const float a0 = bflo(rl[i_]), a1 = bfhi(rl[i_]); \
        const float f0 = a0 >= 0.f ? 1.0f - a0 : -a0, f1 = a1 >= 0.f ? 1.0f - a1 : -a1; kk0[i_] = a0 >= 0.f ? a0 : 1.0f + a0; kk1[i_] = a1 >= 0.f ? a1 : 1.0f + a1; \
        r0_ *= f0; r1_ *= f1; cs0[i_] = r0_; cs1[i_] = r1_; } *(LAS f32x2*)(L + O_PART + (tq * 128 + 2 * dp) * 4) = (f32x2){r0_, r1_}; } while (0)
#define R3_PREP(set) do { LAS unsigned char* B_ = L + (set) * SET; f32x2 pre = (f32x2){1.f, 1.f}, tot = (f32x2){1.f, 1.f}; \
        _Pragma("unroll") for (int p_ = 0; p_ < 8; ++p_) { const f32x2 v_ = *(const LAS f32x2*)(L + O_PART + (p_ * 128 + 2 * dp) * 4); tot *= v_; if (p_ < tq) pre *= v_; } \
        float ka_[4], kb_[4]; \
        _Pragma("unroll") for (int i_ = 0; i_ < 4; ++i_) { const int t_ = 4 * tq + i_; const float eb0 = pre[0] * cs0[i_], eb1 = pre[1] * cs1[i_]; \
            const float kh0 = kk0[i_] * __builtin_amdgcn_rcpf(eb0), kh1 = kk1[i_] * __builtin_amdgcn_rcpf(eb1); \
            *(LAS unsigned*)(B_ + O_QH + t_ * 272 + pd) = pk2(bflo(rq[i_]) * eb0, bfhi(rq[i_]) * eb1); *(LAS unsigned*)(B_ + O_KH + t_ * 272 + pd) = pk2(kh0, kh1); ka_[i_] = kh0 * tot[0]; kb_[i_] = kh1 * tot[1]; } \
        *(LAS u32x2*)(B_ + O_KLT + (2 * dp) * 80 + tq * 8) = (u32x2){pk2(ka_[0], ka_[1]), pk2(ka_[2], ka_[3])}; *(LAS u32x2*)(B_ + O_KLT + (2 * dp + 1) * 80 + tq * 8) = (u32x2){pk2(kb_[0], kb_[1]), pk2(kb_[2], kb_[3])}; \
        *(LAS u32x2*)(B_ + O_VT + (2 * dp) * 80 + tq * 8) = (u32x2){(rv[0] & 0xffffu) | (rv[1] << 16), (rv[2] & 0xffffu) | (rv[3] << 16)}; \
        *(LAS u32x2*)(B_ + O_VT + (2 * dp + 1) * 80 + tq * 8) = (u32x2){(rv[0] >> 16) | (rv[1] & 0xffff0000u), (rv[2] >> 16) | (rv[3] & 0xffff0000u)}; \
        if (tq == 0) *(LAS f32x2*)(B_ + O_EBL + (2 * dp) * 4) = tot; } while (0)
        R3_LOAD(0, rq, rl, rv); gsr = __builtin_nontemporal_load((const GAS u32x4*)(gs_u + gi0)); R3_LOAD(1, nq, nl, nv);
        R3_WALK();
        __syncthreads();
        R3_PREP(0);
        R3_ROT(); R3_LOAD(2, nq, nl, nv);
        __syncthreads();
        for (int it = 0; it < SEQ / 32; ++it) {
            const LAS unsigned char* C_ = L + (it & 1) * SET;
            const bool more = it + 1 < SEQ / 32;
            if (more) R3_WALK();
            if (w < 3) {
                const int tt = (w + 1) >> 1, st = w >> 1;
                f32x4 a = ZERO4;
#pragma unroll
                for (int ks = 0; ks < 4; ++ks) { const bf16x8 qa = *(const LAS bf16x8*)(C_ + O_QH + (16 * tt + c16) * 272 + ks * 64 + g * 16), kb = *(const LAS bf16x8*)(C_ + O_KH + (16 * st + c16) * 272 + ks * 64 + g * 16);
                    a = MFMA16(qa, kb, a); }
#pragma unroll
                for (int r = 0; r < 4; ++r) { const int t = 16 * tt + 4 * g + r, s = 16 * st + c16; *(LAS bf16*)(L + O_ATT + t * 80 + s * 2) = f2bf(s <= t ? a[r] : 0.f); }
            } else if (w == 3) {
#pragma unroll
                for (int r = 0; r < 4; ++r) { const int t = 4 * g + r, s = 16 + c16; *(LAS bf16*)(L + O_ATT + t * 80 + s * 2) = (bf16)0; }
            }
            __syncthreads();
            if (more) { R3_PREP((it + 1) & 1); R3_ROT(); if (it + 3 < SEQ / 32) R3_LOAD(it + 3, nq, nl, nv); gsn = __builtin_nontemporal_load((const GAS u32x4*)(gs_u + ((unsigned)((it + 1) * 32 * HD) + gi0))); }
            {
                const bf16x8 bV = *(const LAS bf16x8*)(C_ + O_VT + (16 * w + c16) * 80 + g * 16);
                f32x4 o[2];
#pragma unroll
                for (int tt = 0; tt < 2; ++tt) { const bf16x8 aA = *(const LAS bf16x8*)(L + O_ATT + (16 * tt + c16) * 80 + g * 16); o[tt] = MFMA16(aA, bV, ZERO4); }
#pragma unroll
                for (int ks = 0; ks < 4; ++ks) {
                    const u32x4 sw = (u32x4){pk2(S[2 * ks][0], S[2 * ks][1]), pk2(S[2 * ks][2], S[2 * ks][3]), pk2(S[2 * ks + 1][0], S[2 * ks + 1][1]), pk2(S[2 * ks + 1][2], S[2 * ks + 1][3])};
                    const bf16x8 bS = __builtin_bit_cast(bf16x8, sw);
#pragma unroll
                    for (int tt = 0; tt < 2; ++tt) { const bf16x8 aQ = *(const LAS bf16x8*)(C_ + O_QH + (16 * tt + c16) * 272 + ks * 64 + g * 16); o[tt] = MFMA16(aQ, bS, o[tt]); } }
#pragma unroll
                for (int dt = 0; dt < 8; ++dt) { const f32x4 e4 = *(const LAS f32x4*)(C_ + O_EBL + (16 * dt + 4 * g) * 4); const bf16x8 aK = *(const LAS bf16x8*)(C_ + O_KLT + (16 * dt + c16) * 80 + g * 16);
                    S[dt] = MFMA16(aK, bV, S[dt] * e4); }
#pragma unroll
                for (int tt = 0; tt < 2; ++tt)
#pragma unroll
                    for (int r = 0; r < 4; ++r) ((LAS float*)(L + O_OB))[(16 * tt + 4 * g + r) * 132 + 16 * w + c16] = o[tt][r];
            }
            __syncthreads();
            {
                const LAS unsigned char* op = L + O_OB + (((4 * w + (lane >> 4)) * 132) + (lane & 15) * 8) * 4;
                const f32x4 a = *(const LAS f32x4*)op, b_ = *(const LAS f32x4*)(op + 16);
                float ss = (a[0] * a[0] + a[1] * a[1]) + (a[2] * a[2] + a[3] * a[3]) + (b_[0] * b_[0] + b_[1] * b_[1]) + (b_[2] * b_[2] + b_[3] * b_[3]);
                ss += dppf<0xB1>(ss); ss += dppf<0x4E>(ss); ss += dppf<0x141>(ss); ss += dppf<0x140>(ss);
                const float rstd = 1.0f / sqrtf(ss * (1.0f / HD) + NORM_EPS);
                const u32x4 gs = gsr; const f32x4 an = a * rstd * gn0, bn = b_ * rstd * gn1;
                u32x4 w_; w_.x = pk2(an[0] * bflo(gs.x), an[1] * bfhi(gs.x)); w_.y = pk2(an[2] * bflo(gs.y), an[3] * bfhi(gs.y)); w_.z = pk2(bn[0] * bflo(gs.z), bn[1] * bfhi(gs.z)); w_.w = pk2(bn[2] * bflo(gs.w), bn[3] * bfhi(gs.w));
                *(GAS u32x4*)(o0_u + ((unsigned)(it * 32 * DM) + go0)) = w_;
                gsr = gsn;
            }
        }
#undef R3_LOAD
#undef R3_ROT
#undef R3_WALK
#undef R3_PREP
        __syncthreads();
    }
}

namespace at2 {
typedef float f32x16 __attribute__((ext_vector_type(16)));
#define AT_KSWZ(row, colB) ((row) * 256 + ((colB) ^ (((row) & 7) << 4)))
#define AT_SBAR() __builtin_amdgcn_sched_barrier(0)
constexpr int SHM_V = 16384, SHM_K = 16384;
constexpr float THRL = 11.5f;
#ifndef AT_SDEPTH
#define AT_SDEPTH 2
#endif
__device__ __forceinline__ int crow(int r, int hi) { return (r & 3) + 8 * (r >> 2) + 4 * hi; }
__device__ __forceinline__ u32x2 split3(float x) {
    const unsigned w0 = pk2(x, 0.f) & 0xffffu; const float r1 = x - __uint_as_float(w0 << 16);
    const unsigned w1 = pk2(r1, 0.f) & 0xffffu; const float r2 = r1 - __uint_as_float(w1 << 16);
    const unsigned w2 = pk2(r2, 0.f) & 0xffffu;
    return (u32x2){w0 | (w1 << 16), w2};
}
template <bool FIRST> __device__ __forceinline__ void partialSM(f32x16& p0, f32x16& p1, float& m_reg, float& alpha, u32x2& qm, bool diag, int thr_in, int hi) {
    const float NEG = -__builtin_inff();
    if (diag) { int thr = thr_in; asm volatile("" : "+v"(thr));
#pragma unroll
        for (int r = 0; r < 16; ++r) { const int c = (r & 3) + 8 * (r >> 2); if (c > thr) p0[r] = NEG; if (c + 32 > thr) p1[r] = NEG; }
    }
    float pmax = p0[0];
#pragma unroll
    for (int r = 1; r < 16; ++r) pmax = fmaxf(pmax, p0[r]);
#pragma unroll
    for (int r = 0; r < 16; ++r) pmax = fmaxf(pmax, p1[r]);
    { auto rr = __builtin_amdgcn_permlane32_swap(__float_as_uint(pmax), __float_as_uint(pmax), false, false);
      pmax = fmaxf(__uint_as_float(rr[0]), __uint_as_float(rr[1])); }
    if (!FIRST && __builtin_expect(__all(pmax <= THRL), 1)) { alpha = 1.f; }
    else { const float d = FIRST ? pmax : fmaxf(pmax, 0.f);
        alpha = FIRST ? 1.f : __builtin_amdgcn_exp2f(-d); m_reg = FIRST ? d : m_reg + d;
#pragma unroll
        for (int r = 0; r < 16; ++r) { p0[r] -= d; p1[r] -= d; }
        const u32x2 s3 = split3(-m_reg); qm.x = hi ? 0u : s3.x; qm.y = hi ? 0u : s3.y; }
#pragma unroll
    for (int r = 0; r < 16; ++r) p0[r] = __builtin_amdgcn_exp2f(p0[r]);
    asm volatile("" : "+v"(p0), "+v"(p1));
}
__device__ __forceinline__ void finishSM(f32x16& p0, f32x16& p1, float alpha, float& l_reg, bf16x8& pa0, bf16x8& pa1, bf16x8& pa2, bf16x8& pa3) {
#pragma unroll
    for (int r = 0; r < 16; ++r) p1[r] = __builtin_amdgcn_exp2f(p1[r]);
    float ps = 0.f;
#pragma unroll
    for (int r = 0; r < 16; ++r) ps += p0[r];
#pragma unroll
    for (int r = 0; r < 16; ++r) ps += p1[r];
    { auto rr = __builtin_amdgcn_permlane32_swap(__float_as_uint(ps), __float_as_uint(ps), false, false);
      ps = __uint_as_float(rr[0]) + __uint_as_float(rr[1]); }
    l_reg = l_reg * alpha + ps;
#define AT_PK4(P, BASE, OUT) do { const u32x4 w_ = {pk2(P[BASE + 0], P[BASE + 1]), pk2(P[BASE + 2], P[BASE + 3]), pk2(P[BASE + 4], P[BASE + 5]), pk2(P[BASE + 6], P[BASE + 7])}; \
    OUT = __builtin_bit_cast(bf16x8, w_); } while (0)
    AT_PK4(p0, 0, pa0); AT_PK4(p0, 8, pa1); AT_PK4(p1, 0, pa2); AT_PK4(p1, 8, pa3);
#undef AT_PK4
}
__device__ __forceinline__ void qkt(f32x16& p0, f32x16& p1, const LAS unsigned char* Ks, const int (&kb)[4], const bf16x8* qr, u32x2 qme) {
    f32x16 z;
#pragma unroll
    for (int r = 0; r < 16; ++r) z[r] = 0.f;
    const s16x4 ones = __builtin_bit_cast(s16x4, (u32x2){0x3F803F80u, 0x3F803F80u}), qb = __builtin_bit_cast(s16x4, qme);
    p0 = __builtin_amdgcn_mfma_f32_32x32x8bf16_1k(ones, qb, z, 0, 0, 0);
    p1 = __builtin_amdgcn_mfma_f32_32x32x8bf16_1k(ones, qb, z, 0, 0, 0);
#pragma unroll
    for (int d0 = 0; d0 < 8; ++d0) { const LAS unsigned char* ka = Ks + kb[d0 & 3] + (d0 >> 2) * 128;
        const bf16x8 b0 = *(const LAS bf16x8*)ka;
        const bf16x8 b1 = *(const LAS bf16x8*)(ka + 8192);
        p0 = __builtin_amdgcn_mfma_f32_32x32x16_bf16(b0, qr[d0], p0, 0, 0, 0);
        p1 = __builtin_amdgcn_mfma_f32_32x32x16_bf16(b1, qr[d0], p1, 0, 0, 0); }
}
__device__ __forceinline__ int v_st(int k, int c) { return ((k >> 3) * 4 + (c >> 5)) * 512 + ((k & 7) * 32 + (c & 31)) * 2; }
__device__ __forceinline__ int v_rd_base(int lane) { return ((lane & 3) << 3) | (((lane >> 2) & 3) << 6) | (((lane >> 4) & 1) << 5) | (((lane >> 5) & 1) << 8); }
constexpr int v_rd_off(int d0, int ks, int half) { return d0 * 512 + ks * 4096 + half * 2048; }
template <int OFF> __device__ __forceinline__ s16x4 tr_read(int vb) {
    s16x4 r; asm volatile("ds_read_b64_tr_b16 %0, %1 offset:%2" : "=&v"(r) : "v"(vb), "i"(OFF) : "memory"); return r;
}
template <int D0> __device__ __forceinline__ void pv_one(f32x16& od, int vb, bf16x8 pa0, bf16x8 pa1, bf16x8 pa2, bf16x8 pa3) {
    const s16x4 l0 = tr_read<v_rd_off(D0, 0, 0)>(vb), h0 = tr_read<v_rd_off(D0, 0, 1)>(vb), l1 = tr_read<v_rd_off(D0, 1, 0)>(vb), h1 = tr_read<v_rd_off(D0, 1, 1)>(vb);
    const s16x4 l2 = tr_read<v_rd_off(D0, 2, 0)>(vb), h2 = tr_read<v_rd_off(D0, 2, 1)>(vb), l3 = tr_read<v_rd_off(D0, 3, 0)>(vb), h3 = tr_read<v_rd_off(D0, 3, 1)>(vb);
    asm volatile("s_waitcnt lgkmcnt(0)" ::: "memory"); AT_SBAR();
#define AT_PK(Lo, Hi) (bf16x8){Lo[0], Lo[1], Lo[2], Lo[3], Hi[0], Hi[1], Hi[2], Hi[3]}
    od = __builtin_amdgcn_mfma_f32_32x32x16_bf16(pa0, AT_PK(l0, h0), od, 0, 0, 0);
    od = __builtin_amdgcn_mfma_f32_32x32x16_bf16(pa1, AT_PK(l1, h1), od, 0, 0, 0);
    od = __builtin_amdgcn_mfma_f32_32x32x16_bf16(pa2, AT_PK(l2, h2), od, 0, 0, 0);
    od = __builtin_amdgcn_mfma_f32_32x32x16_bf16(pa3, AT_PK(l3, h3), od, 0, 0, 0);
#undef AT_PK
}
__device__ __forceinline__ void pv_d0(f32x16* o, int vb, bf16x8 pa0, bf16x8 pa1, bf16x8 pa2, bf16x8 pa3) {
    pv_one<0>(o[0], vb, pa0, pa1, pa2, pa3); pv_one<1>(o[1], vb, pa0, pa1, pa2, pa3); pv_one<2>(o[2], vb, pa0, pa1, pa2, pa3); pv_one<3>(o[3], vb, pa0, pa1, pa2, pa3);
}
}

template <bool LEAD> __device__ __forceinline__ void p7_body(Frame& F) {
    using namespace at2;
    LAS unsigned char* L = F.lds;
    constexpr int O_K = 0, O_V = 4 * SHM_K, O_WS = 4 * SHM_K + 4 * SHM_V, O_KM = O_WS + 2048, O_OST = O_K + 2 * SHM_K;
    const int tid = F.tid, lane = F.lane, wid = F.wave, r32 = lane & 31, hi = lane >> 5;
    const bf16* QB = F.S4; const bf16* KB = F.S2; const bf16* VB = F.S3; const bf16* ZS = F.S5; bf16* A1 = F.S6;
    const float NEG_INF = -__builtin_inff();
    LAS float* li_l = (LAS float*)(L + O_WS) + wid * 64; LAS float* al_l = li_l + 32;
    const int vb0 = (int)(unsigned)(uintptr_t)(L + O_V) + v_rd_base(lane);
    int kb[4];
    { int r_ = lane; asm volatile("" : "+v"(r_)); const int rr_ = r_ & 31, base_ = rr_ * 256 + ((((r_ >> 5) ^ rr_) & 1) << 4), x_ = (rr_ >> 1) & 3;
#pragma unroll
      for (int i = 0; i < 4; ++i) kb[i] = base_ + ((i ^ x_) << 5); }
    unsigned kvo0, kvo1, vvo;
    { int ln_ = lane; asm volatile("" : "+v"(ln_));
      const int rq = ln_ >> 4, cx = ln_ & 15;
      kvo0 = (unsigned)((8 * wid + rq) * 256 + ((cx ^ rq) << 4));
      kvo1 = (unsigned)((8 * wid + 4 + rq) * 256 + ((cx ^ (4 + rq)) << 4));
      const int key = 8 * wid + ((ln_ >> 2) & 7);
      vvo = (unsigned)(key * 256 + (ln_ >> 5) * 64 + (ln_ & 3) * 16); }
    const int ngrp = F.G / 4, mem = F.vcu & 3, bh0 = F.vcu >> 2;
    const int nun = (ngrp > 0 && bh0 < BATCH * NH) ? 2 * ((BATCH * NH - bh0 + ngrp - 1) / ngrp) : 0;
    bf16x8 qr[8];
    float kmr[2];
#define AT_UBH(u) (bh0 + ((u) >> 1) * ngrp)
#define AT_UJ(u) (((u) & 1) ? 7 - mem : mem)
#define AT_KROW(bhv, jv, t) ((size_t)(bhv) * pg8::HM_ROWS + (size_t)(((t) < 4) ? (jv) : (((t) - 4) >> 2)) * 256 + (size_t)((t) & 3) * 64)
#define AT_DMA(sb, bhv, jv, t) do { const size_t k0_ = AT_KROW(bhv, jv, t) * HD; const char* vt_ = (const char*)(VB + k0_); const char* kt_ = (const char*)(KB + k0_); \
    __builtin_amdgcn_global_load_lds((const unsigned*)(kt_ + kvo0), (LAS unsigned*)(L + O_K + (sb) + wid * 2048), 16, 0, 0); \
    __builtin_amdgcn_global_load_lds((const unsigned*)(kt_ + kvo1), (LAS unsigned*)(L + O_K + (sb) + wid * 2048 + 1024), 16, 0, 0); \
    __builtin_amdgcn_global_load_lds((const unsigned*)(vt_ + vvo), (LAS unsigned*)(L + O_V + (sb) + wid * 2048), 16, 0, 0); \
    __builtin_amdgcn_global_load_lds((const unsigned*)(vt_ + 128 + vvo), (LAS unsigned*)(L + O_V + (sb) + wid * 2048 + 1024), 16, 0, 0); } while (0)
#define AT_BAR(N) do { AT_SBAR(); asm volatile("s_waitcnt vmcnt(" #N ")" ::: "memory"); __builtin_amdgcn_s_barrier(); AT_SBAR(); } while (0)
#define AT_RESC(a) do { if (__any((a) < 1.f)) { if (hi == 0) al_l[r32] = (a); asm volatile("s_waitcnt lgkmcnt(0)" ::: "memory"); \
    _Pragma("unroll") for (int d_ = 0; d_ < 4; ++d_) _Pragma("unroll") for (int r_ = 0; r_ < 16; ++r_) o[d_][r_] *= al_l[crow(r_, hi)]; } } while (0)
#define AT_PSM(P0, P1, AL, t) partialSM<false>(P0, P1, m_reg, AL, qm, (t) < 4 && ((t) & 3) == (wid >> 1), qrel - (64 * ((t) & 3) + 4 * hi), hi)
#define AT_QME(t) ({ const bool rs_ = ((t) < 4) ? (((t) & 3) <= (wid >> 1)) : (((mk >> (((t) - 4) >> 2)) & 1u) != 0u); (u32x2){rs_ ? qm.x : negpk, rs_ ? qm.y : 0u}; })
#define AT_UNIT_REQ(u) do { const int bhn_ = AT_UBH(u), jn_ = AT_UJ(u); const bf16* qn_ = QB + ((size_t)(bhn_ >> 3) * SEQ + (size_t)jn_ * 256) * DM + (bhn_ & 7) * HD; \
    int ln_ = lane; asm volatile("" : "+v"(ln_)); const unsigned qo_ = (unsigned)((32 * wid + (ln_ & 31)) * DM + (ln_ >> 5) * 8); \
    _Pragma("unroll") for (int d0 = 0; d0 < 8; ++d0) qr[d0] = *(const GAS bf16x8*)(qn_ + (qo_ + d0 * 16)); \
    AT_DMA(0, bhn_, jn_, 0); AT_DMA(SHM_K, bhn_, jn_, 1); \
    if (((u) & 1) == 0) { _Pragma("unroll") for (int i_ = 0; i_ < 2; ++i_) { const int e_ = tid + 512 * i_; const float* kp_ = F.KM + ((size_t)(bhn_ * 8 + (e_ >> 7)) * 2) * 128 + (e_ & 127); kmr[i_] = kp_[0] + kp_[128]; } } } while (0)
    if (nun > 0) AT_UNIT_REQ(0);
    for (int u = 0; u < nun; ++u) {
        const int bh = AT_UBH(u), j = AT_UJ(u), b = bh >> 3, h = bh & 7, hcol = h * HD;
        const size_t qrow0 = (size_t)b * SEQ + (size_t)j * 256;
        if ((u & 1) == 0) {
            __syncthreads();
            ((LAS float*)(L + O_KM))[tid] = kmr[0]; ((LAS float*)(L + O_KM))[tid + 512] = kmr[1];
            __syncthreads();
        }
        const int qrel = 32 * wid + r32;
        const int NT = 4 * (j + 1);
        float m_reg = 0.f, l_reg = 0.f; f32x16 o[4];
#pragma unroll
        for (int d = 0; d < 4; ++d)
#pragma unroll
            for (int r = 0; r < 16; ++r) o[d][r] = 0.f;
        f32x16 pA0, pA1, pB0, pB1; float alA, alB; bf16x8 pa0, pa1, pa2, pa3; u32x2 qm = (u32x2){0u, 0u}; const unsigned negpk = hi ? 0u : 0x0000FF80u;
        unsigned mk = 0u;
        {
            float gt[7];
#pragma unroll
            for (int nb = 0; nb < 7; ++nb) { float s_ = NEG_INF;
                if (nb < j) { s_ = 0.f; const LAS f32x4* kp = (const LAS f32x4*)(L + O_KM + (nb * 128 + hi * 8) * 4);
#pragma unroll
                    for (int d0 = 0; d0 < 8; ++d0) { const u32x4 q = __builtin_bit_cast(u32x4, qr[d0]); const f32x4 k0 = kp[4 * d0], k1 = kp[4 * d0 + 1];
                        s_ += (bflo(q.x) * k0[0] + bfhi(q.x) * k0[1]) + (bflo(q.y) * k0[2] + bfhi(q.y) * k0[3]) + (bflo(q.z) * k1[0] + bfhi(q.z) * k1[1]) + (bflo(q.w) * k1[2] + bfhi(q.w) * k1[3]); }
                    s_ += __shfl_xor(s_, 32); }
                gt[nb] = s_; }
#pragma unroll
            for (int nb = 0; nb < 7; ++nb) { int cnt = 0;
#pragma unroll
                for (int mb = 0; mb < 7; ++mb) if (mb != nb) cnt += ((gt[mb] > gt[nb]) || (gt[mb] == gt[nb] && mb < nb)) ? 1 : 0;
                if (nb < j && cnt < 3) mk |= 1u << nb; }
        }
        AT_SBAR(); __builtin_amdgcn_s_barrier(); AT_SBAR();
        AT_DMA(2 * SHM_K, bh, j, 2);
        AT_BAR(4);
        qkt(pA0, pA1, L + O_K, kb, qr, qm); partialSM<true>(pA0, pA1, m_reg, alA, qm, (wid >> 1) == 0, qrel - 4 * hi, hi);
#define AT_STEP(PN0, PN1, KS, ALN, PO0, PO1, ALO, VS, TN, LOADSTMT) do { \
        if constexpr (LEAD) { AT_SBAR(); qkt(PN0, PN1, L + O_K + (KS), kb, qr, AT_QME(TN)); AT_SBAR(); finishSM(PO0, PO1, ALO, l_reg, pa0, pa1, pa2, pa3); AT_SBAR(); LOADSTMT; AT_SBAR(); \
                    pv_d0(o, vb0 + (VS), pa0, pa1, pa2, pa3); AT_SBAR(); AT_PSM(PN0, PN1, ALN, TN); AT_SBAR(); } \
        else                { AT_SBAR(); finishSM(PO0, PO1, ALO, l_reg, pa0, pa1, pa2, pa3); AT_SBAR(); qkt(PN0, PN1, L + O_K + (KS), kb, qr, AT_QME(TN)); AT_SBAR(); LOADSTMT; AT_SBAR(); \
                    AT_PSM(PN0, PN1, ALN, TN); AT_SBAR(); pv_d0(o, vb0 + (VS), pa0, pa1, pa2, pa3); AT_SBAR(); } } while (0)
        int kofs = 0;
        for (int n = 1; n + 1 < NT; n += 2) {
            AT_STEP(pB0, pB1, SHM_K + kofs, alB, pA0, pA1, alA, kofs, n, AT_DMA(3 * SHM_K - kofs, bh, j, n + 2));
            AT_RESC(alB); AT_BAR(4);
            const bool more = n + 3 < NT;
            AT_STEP(pA0, pA1, 2 * SHM_K - kofs, alA, pB0, pB1, alB, SHM_V + kofs, n + 1, if (more) AT_DMA(kofs, bh, j, n + 3));
            AT_RESC(alA); if (more) AT_BAR(4); else AT_BAR(0);
            kofs ^= 2 * SHM_K;
        }
        AT_STEP(pB0, pB1, 3 * SHM_K, alB, pA0, pA1, alA, 2 * SHM_V, NT - 1, if (u + 1 < nun) AT_UNIT_REQ(u + 1));
        AT_SBAR(); __builtin_amdgcn_s_barrier(); AT_SBAR();
        AT_RESC(alB);
        finishSM(pB0, pB1, alB, l_reg, pa0, pa1, pa2, pa3); AT_SBAR();
        pv_d0(o, vb0 + 3 * SHM_V, pa0, pa1, pa2, pa3);
#undef AT_STEP
        if (hi == 0) li_l[r32] = l_reg; asm volatile("s_waitcnt lgkmcnt(0)" ::: "memory");
        {
            LAS unsigned char* st = L + O_OST + wid * 4096;
            int ln2_ = lane; asm volatile("" : "+v"(ln2_));
            const bf16* zs_u = ZS + qrow0 * DM + hcol; bf16* a1_u = A1 + qrow0 * DM + hcol;
            const unsigned ro0 = (unsigned)((32 * wid + (ln2_ >> 4)) * DM + (ln2_ & 15) * 8); const int so_ = (ln2_ >> 4) * 256 + (ln2_ & 15) * 16;
            u32x4 zz[8];
#pragma unroll
            for (int i = 0; i < 8; ++i) zz[i] = *(const GAS u32x4*)(zs_u + (ro0 + i * 4 * DM));
            LAS unsigned char* stw = st + (ln2_ >> 5) * 1024 + (ln2_ & 31) * 2;
            const LAS float* lil = li_l + 4 * (ln2_ >> 5);
#pragma unroll
            for (int ps = 0; ps < 2; ++ps) {
#pragma unroll
                for (int r8 = 0; r8 < 8; ++r8) { const int r = 8 * ps + r8, ro_ = (r8 & 3) + 8 * (r8 >> 2); const float rl = __builtin_amdgcn_rcpf(lil[(r & 3) + 8 * (r >> 2)]);
#pragma unroll
                    for (int d0 = 0; d0 < 4; ++d0) *(LAS bf16*)(stw + ro_ * 256 + d0 * 64) = f2bf(o[d0][r] * rl); }
#pragma unroll
                for (int ii = 0; ii < 4; ++ii) { const int i = 4 * ps + ii; const u32x4 z = zz[i]; const u32x4 ov = *(const LAS u32x4*)(st + so_ + ii * 1024);
                    u32x4 w_; w_.x = pk2(bflo(ov.x) * bflo(z.x), bfhi(ov.x) * bfhi(z.x)); w_.y = pk2(bflo(ov.y) * bflo(z.y), bfhi(ov.y) * bfhi(z.y));
                    w_.z = pk2(bflo(ov.z) * bflo(z.z), bfhi(ov.z) * bfhi(z.z)); w_.w = pk2(bflo(ov.w) * bflo(z.w), bfhi(ov.w) * bfhi(z.w));
                    *(GAS u32x4*)(a1_u + (ro0 + i * 4 * DM)) = w_; }
            }
        }
    }
    asm volatile("s_waitcnt vmcnt(0)" ::: "memory");
    __syncthreads();
#undef AT_UBH
#undef AT_UJ
#undef AT_KROW
#undef AT_DMA
#undef AT_BAR
#undef AT_RESC
#undef AT_PSM
#undef AT_QME
#undef AT_UNIT_REQ
}
__device__ __forceinline__ void p7_attention2(Frame& F) { if (F.wave < 4) p7_body<true>(F); else p7_body<false>(F); }

struct Args { const void* in[15]; float* out; unsigned char* ws; int ph_lo, ph_hi; };
__global__ void __launch_bounds__(NWAVES * 64, 2) fwd(Args args) {
    extern __shared__ __attribute__((aligned(16))) unsigned char lds[];
    Frame F;
    F.lds = (LAS unsigned char*)lds;
    F.tid = threadIdx.x; F.lane = F.tid & 63; F.wave = __builtin_amdgcn_readfirstlane(F.tid >> 6);
    F.G = gridDim.x; { const int bx = blockIdx.x; F.vcu = (F.G % 8 == 0) ? (bx % 8) * (F.G / 8) + bx / 8 : bx; }
    unsigned char* ws = args.ws;
    F.x = (const float*)args.in[0]; F.c = (const float*)args.in[1]; F.pos = (const int*)args.in[2]; F.mod_w = (const float*)args.in[3]; F.mod_b = (const float*)args.in[4];
    F.pre_g = (const float*)args.in[5]; F.post_g = (const float*)args.in[6]; F.a_w_in = (const float*)args.in[7]; F.a_w_out = (const float*)args.in[8]; F.a_gn = (const float*)args.in[9];
    F.a_lb = (const float*)args.in[10]; F.kv_g = (const float*)args.in[11]; F.w_kv = (const float*)args.in[12]; F.b_w_in = (const float*)args.in[13]; F.b_w_out = (const float*)args.in[14];
    F.out = args.out;
    F.Win0 = (bf16*)(ws + WS_WIN0); F.Wout0 = (bf16*)(ws + WS_WOUT0); F.Wkv = (bf16*)(ws + WS_WKV); F.Win1 = (bf16*)(ws + WS_WIN1); F.Wout1 = (bf16*)(ws + WS_WOUT1);
    F.MOD = (float*)(ws + WS_MOD); F.LB = (float*)(ws + WS_LB); F.TAB = (float*)(ws + WS_TAB); F.KM = (float*)(ws + WS_KM);
    F.S0 = (bf16*)(ws + WS_S0); F.S1 = (bf16*)(ws + WS_S1); F.S2 = (bf16*)(ws + WS_S2); F.S3 = (bf16*)(ws + WS_S3); F.S4 = (bf16*)(ws + WS_S4); F.S5 = (bf16*)(ws + WS_S5); F.S6 = (bf16*)(ws + WS_S6);
    volatile LAS unsigned* MISC = (volatile LAS unsigned*)(F.lds + MISC_OFF);
    for (int u = F.tid; u < (LDS_BYTES - LDSCTL_OFF) / 4; u += NWAVES * 64) ((LAS unsigned*)(F.lds + LDSCTL_OFF))[u] = 0u;
    __syncthreads();
    XcdBarrier bar; bar.bar = (unsigned*)(ws + WS_CTL) + CW_BAR; bar.x = 0; bar.st = nullptr;
    if (N_LAUNCHES == 1) bar = xcd_barrier_post((unsigned*)(ws + WS_CTL) + CW_BAR, MISC + 8);
    const int lo = args.ph_lo, hi = args.ph_hi;
#define IN(k) (lo <= (k) && (k) < hi)
#define SEAM(k) do { if (IN(k) && IN((k) + 1)) xcd_barrier(bar); } while (0)
#define WGSEAM(k) do { if (IN(k) && IN((k) + 1)) { asm volatile("s_waitcnt vmcnt(0)" ::: "memory"); __syncthreads(); } } while (0)

    if (IN(0)) { p0_prologue(F); } SEAM(0);
    if (IN(1)) { p1_modnorm(F); } SEAM(1);
    if (IN(2)) {
        pg8::Gemm g{F.S0, F.Win0, M, 4096, DM}; pg8::StaticOrder S; S.init(M, 4096, F.G, (int)blockIdx.x);
        pg8::EpiL0 E{F.S1, F.S2, F.S3, F.S4, F.LB};
        pg8::gemm_phase<pg8::EpiL0, pg8::StaticOrder, true, true>(F.lds, g, S, E);
    } SEAM(2);
    if (IN(3)) { p3_recurrence3(F); } SEAM(3);
    if (IN(4)) {
        pg8::Gemm g{F.S5, F.Wout0, M, DM, DM}; pg8::PanelOrder S; S.init(M, DM, F.G, F.vcu);
        pg8::EpiBf16<0> E{F.S6, DM, nullptr, 0, 0, 1.f};
        pg8::gemm_phase<pg8::EpiBf16<0>, pg8::PanelOrder, true, true>(F.lds, g, S, E);
    } WGSEAM(4);
    if (IN(5)) { p5_mid(F); } SEAM(5);
    if (IN(6)) {
        { pg8::Gemm g{F.S1, F.Wkv, M, 2048, DM}; pg8::StaticOrder S; S.init(M, 2048, F.G, (int)blockIdx.x);
          pg8::EpiKV E{F.S2, F.S3, F.pos, F.TAB, F.KM};
          pg8::gemm_phase<pg8::EpiKV, pg8::StaticOrder, true, true>(F.lds, g, S, E); }
        { pg8::Gemm g{F.S0, F.Win1, M, 2048, DM}; pg8::StaticOrder S; S.init(M, 2048, F.G, (int)blockIdx.x);
          pg8::EpiQZ E{F.S4, F.S5, F.pos, F.TAB, QSCALE};
          pg8::gemm_phase<pg8::EpiQZ, pg8::StaticOrder, true, true>(F.lds, g, S, E); }
    } SEAM(6);
    if (IN(7)) { p7_attention2(F); } SEAM(7);
    if (IN(8)) {
        pg8::Gemm g{F.S6, F.Wout1, M, DM, DM}; pg8::PanelOrder S; S.init(M, DM, F.G, F.vcu);
        pg8::EpiBf16<0> E{F.S0, DM, nullptr, 0, 0, 1.f};
        pg8::gemm_phase<pg8::EpiBf16<0>, pg8::PanelOrder, true, true>(F.lds, g, S, E);
    } WGSEAM(8);
    if (IN(9)) { p9_final(F); }
#undef IN
#undef SEAM
#undef WGSEAM
}

extern "C" void kernel_launch(void* const* d_in, const int* in_sizes, int n_in, void* d_out, int out_size, void* d_ws, size_t ws_size, hipStream_t stream) {
    static int grid = 0;
    if (grid == 0) {
        if (n_in != 15 || in_sizes[0] != M * DM || out_size != M * DM || ws_size < WS_END) { fprintf(stderr, "kernel_launch: unexpected shapes (n_in %d, in0 %d, out %d, ws %zu); nothing launched\n", n_in, n_in > 0 ? in_sizes[0] : -1, out_size, ws_size); grid = -1; return; }
        int dev = 0, cus = 0, per_cu = 0;
        if (hipGetDevice(&dev) != hipSuccess || hipDeviceGetAttribute(&cus, hipDeviceAttributeMultiprocessorCount, dev) != hipSuccess) { grid = -1; return; }
        if (hipFuncSetAttribute((const void*)fwd, hipFuncAttributeMaxDynamicSharedMemorySize, LDS_BYTES) != hipSuccess) { fprintf(stderr, "kernel_launch: hipFuncSetAttribute failed\n"); grid = -1; return; }
        if (hipOccupancyMaxActiveBlocksPerMultiprocessor(&per_cu, (const void*)fwd, NWAVES * 64, LDS_BYTES) != hipSuccess || per_cu < 1) { fprintf(stderr, "kernel_launch: occupancy query says %d blocks per CU\n", per_cu); }
        (void)hipGetLastError();
        grid = cus;
    }
    if (grid < 0) return;
    static_assert((size_t)(CW_BAR + XCD_BAR_WORDS) * 4 <= CTL_ZERO_BYTES, "the zeroed control region must cover the barrier words");
    if (hipMemsetAsync((char*)d_ws + WS_CTL, 0, CTL_ZERO_BYTES, stream) != hipSuccess) { fprintf(stderr, "kernel_launch: memset failed\n"); return; }
    Args a{};
    for (int i = 0; i < 15; ++i) a.in[i] = d_in[i];
    a.out = (float*)d_out; a.ws = (unsigned char*)d_ws;
    for (int li = 0; li < N_LAUNCHES; ++li) {
        a.ph_lo = (N_LAUNCHES == 1) ? 0 : li; a.ph_hi = (N_LAUNCHES == 1) ? NPH : li + 1;
        hipLaunchKernelGGL(fwd, dim3(grid), dim3(NWAVES * 64), LDS_BYTES, stream, a);
        const hipError_t le = hipPeekAtLastError();
        if (le != hipSuccess) { fprintf(stderr, "kernel_launch: launch %d failed: %s\n", li, hipGetErrorName(le)); break; }
    }
}
```

```cpp
#include <hip/hip_runtime.h>
#include <cstdio>
#include <cstdint>
namespace pg8 {
#define PG8_LAS __attribute__((address_space(3)))
typedef unsigned short bf16_t;
typedef short bf16x8 __attribute__((ext_vector_type(8)));
typedef float f32x4 __attribute__((ext_vector_type(4)));
typedef unsigned u32x4 __attribute__((ext_vector_type(4)));
constexpr int BM = 256, BK = 64, HALF = 128, HTB = HALF * BK * 2  , STAGE_BYTES = 8 * HTB, NXCD = 8, WGM = 8;

__host__ __device__ __forceinline__ int lds_byte(int r, int c) { const int st = (r >> 4) * 2 + (c >> 5), rr = r & 15, cc = c & 31, ob = rr * 64 + cc * 2; return st * 1024 + (ob ^ (((ob >> 9) & 1) << 5)); }
__host__ __device__ __forceinline__ void stage_rc(int b, int& R, int& C) { const int st = b / 1024, sb = b % 1024, swz = sb ^ (((sb >> 9) & 1) << 5); R = (st >> 1) * 16 + swz / 64; C = (st & 1) * 32 + (swz % 64) / 2; }
__host__ __device__ __forceinline__ int perm32(int rho) { const int n = rho >> 4, i = rho & 15; return 8 * (i >> 2) + 4 * n + (i & 3); }

struct Unit { int pm, pn; };
struct Gemm { const bf16_t* A; const bf16_t* Bt; int M, N, K; };

struct StaticOrder {
    int nM, nN, nwg, G, c;
    __host__ __device__ void init(int M, int N, int G_, int c_) { nM = M / BM; nN = N / BM; nwg = nM * nN; G = G_; c = c_; }
    __host__ __device__ bool next(int i, Unit& u) const {
        const long L = (long)i * G + c; if (L >= nwg) return false;
        int wgid = (int)L; { const int q = nwg / NXCD, r = nwg % NXCD, xcd = wgid % NXCD, off = wgid / NXCD; wgid = (xcd < r ? xcd * (q + 1) : r * (q + 1) + (xcd - r) * q) + off; }
        const int nig = WGM * nN, gid = wgid / nig, fm = gid * WGM, gsz = (nM - fm) < WGM ? (nM - fm) : WGM;
        u.pm = fm + ((wgid % nig) % gsz); u.pn = (wgid % nig) / gsz; return true;
    }
    __device__ __forceinline__ void a_ready(const Unit&) const {}
    __device__ __forceinline__ void done(const Unit&) const {}
};

typedef float cvt_f32x2_t __attribute__((ext_vector_type(2))); typedef __bf16 cvt_bf16x2_t __attribute__((ext_vector_type(2)));
__device__ __forceinline__ unsigned cvt_pk_bf16(float lo, float hi) { const cvt_f32x2_t v = {lo, hi}; const cvt_bf16x2_t b = __builtin_convertvector(v, cvt_bf16x2_t); return __builtin_bit_cast(unsigned, b); }
typedef float f32x2 __attribute__((ext_vector_type(2)));
__device__ __forceinline__ f32x2 gelu_pk(f32x2 v) {
    const f32x2 av = __builtin_elementwise_abs(v), d = av * 0.2316418882f + 1.0f;
    f32x2 t; t.x = __builtin_amdgcn_rcpf(d.x); t.y = __builtin_amdgcn_rcpf(d.y);
    f32x2 q = t * 0.5307027145f + (-0.7265760135f); q = q * t + 0.7107068705f; q = q * t + (-0.142248368f); q = q * t + 0.127414796f; q = q * t;
    const f32x2 s = (v * v) * (-0.72134752044f);
    f32x2 e; e.x = __builtin_amdgcn_exp2f(s.x); e.y = __builtin_amdgcn_exp2f(s.y);
    const f32x2 m = v * (q * e), r = v - m;
    f32x2 o; o.x = v.x < 0.f ? m.x : r.x; o.y = v.y < 0.f ? m.y : r.y; return o;
}

template <int ACT  > struct EpiBf16 {
    static constexpr bool PERM = true, AFTER_DRAIN = false; static_assert(ACT == 0 || ACT == 1, "EpiBf16: ACT is 0 (none) or 1 (gelu_pk)");
    bf16_t* O; int ldc; const float* bias; int split_cols; size_t split_stride; float scale0;
    __device__ __forceinline__ void operator()(const f32x4 (&acc)[2][2][4][2], const Unit& u, int wr, int wc, int fr, int fq) const {
        const int row0 = u.pm * BM + wr * 64 + fr; int colt = u.pn * BM; bf16_t* base = O;
        float sc = 1.f; if (split_cols) { const int t = colt / split_cols; base += (size_t)t * split_stride; colt -= t * split_cols; if (t == 0) sc = scale0; }
        const int col0 = colt + wc * 32 + 8 * fq, bcol0 = u.pn * BM + wc * 32 + 8 * fq;
        f32x4 bv[2][2];
#pragma unroll
        for (int bj = 0; bj < 2; ++bj)
#pragma unroll
            for (int n = 0; n < 2; ++n) bv[bj][n] = bias ? *(const f32x4*)(bias + bcol0 + bj * HALF + 4 * n) : (f32x4){0.f, 0.f, 0.f, 0.f};
#pragma unroll
        for (int ai = 0; ai < 2; ++ai)
#pragma unroll
            for (int m = 0; m < 4; ++m) { bf16_t* rowp = base + (size_t)(row0 + ai * HALF + m * 16) * ldc + col0;
#pragma unroll
                for (int bj = 0; bj < 2; ++bj) { f32x4 v0 = acc[ai][bj][m][0] + bv[bj][0], v1 = acc[ai][bj][m][1] + bv[bj][1];
                    if (ACT == 1) { f32x2 a = gelu_pk((f32x2){v0[0], v0[1]}), b = gelu_pk((f32x2){v0[2], v0[3]}), c = gelu_pk((f32x2){v1[0], v1[1]}), d = gelu_pk((f32x2){v1[2], v1[3]});
                        v0 = (f32x4){a.x, a.y, b.x, b.y}; v1 = (f32x4){c.x, c.y, d.x, d.y}; }
                    v0 = v0 * sc; v1 = v1 * sc; u32x4 w; w.x = cvt_pk_bf16(v0[0], v0[1]); w.y = cvt_pk_bf16(v0[2], v0[3]); w.z = cvt_pk_bf16(v1[0], v1[1]); w.w = cvt_pk_bf16(v1[2], v1[3]);
                    *(u32x4*)(rowp + bj * HALF) = w; } }
    }
};

struct PanelOrder {
    int nM, nN, G, c;
    __host__ __device__ void init(int M, int N, int G_, int c_) { nM = M / BM; nN = N / BM; G = G_; c = c_; }
    __host__ __device__ bool next(int i, Unit& u) const { const int pm = c + (i / nN) * G; if (pm >= nM) return false; u.pm = pm; u.pn = i % nN; return true; }
    __device__ __forceinline__ void a_ready(const Unit&) const {}
    __device__ __forceinline__ void done(const Unit&) const {}
};

__device__ __forceinline__ float fast_sigmoid(float x) { return __builtin_amdgcn_rcpf(1.0f + __builtin_amdgcn_exp2f(-1.4426950408889634f * x)); }
__device__ __forceinline__ float fast_silu(float x) { return x * fast_sigmoid(x); }
__device__ __forceinline__ u32x4 pack8(const f32x4& v0, const f32x4& v1) { u32x4 w; w.x = cvt_pk_bf16(v0[0], v0[1]); w.y = cvt_pk_bf16(v0[2], v0[3]); w.z = cvt_pk_bf16(v1[0], v1[1]); w.w = cvt_pk_bf16(v1[2], v1[3]); return w; }
__device__ __forceinline__ f32x4 rope4(const f32x4& x, const f32x4& t) { return (f32x4){x[0] * t[0] - x[1] * t[1], x[1] * t[0] + x[0] * t[1], x[2] * t[2] - x[3] * t[3], x[3] * t[2] + x[2] * t[3]}; }
constexpr int LDC = 1024;
constexpr int HM_ROWS = 2048 + 17;
__device__ __forceinline__ size_t hm_base(int pm, int h) { return ((size_t)((pm >> 3) * 8 + h) * HM_ROWS + (size_t)(pm & 7) * 256) * 128; }

struct EpiL0 {
    static constexpr bool PERM = true, AFTER_DRAIN = false;
    bf16_t* QS; bf16_t* LF; bf16_t* VV; bf16_t* GS; const float* lb;
    __device__ __forceinline__ void operator()(const f32x4 (&acc)[2][2][4][2], const Unit& u, int wr, int wc, int fr, int fq) const {
        const int type = u.pn >> 2;
        bf16_t* base = type == 0 ? QS : (type == 1 ? LF : (type == 2 ? VV : GS));
        const int col0 = (u.pn & 3) * BM + wc * 32 + 8 * fq;
        bf16_t* hb = base + hm_base(u.pm, 2 * (u.pn & 3));
        f32x4 lbv[2][2];
#pragma unroll
        for (int bj = 0; bj < 2; ++bj)
#pragma unroll
            for (int n = 0; n < 2; ++n) lbv[bj][n] = (type == 1) ? *(const f32x4*)(lb + col0 + bj * HALF + 4 * n) : (f32x4){0.f, 0.f, 0.f, 0.f};
#pragma unroll
        for (int ai = 0; ai < 2; ++ai)
#pragma unroll
            for (int m = 0; m < 4; ++m) { bf16_t* rowp = hb + (unsigned)((wr * 64 + fr + ai * HALF + m * 16) * 128 + 32 * wc + 8 * fq);
#pragma unroll
                for (int bj = 0; bj < 2; ++bj) { f32x4 v[2] = {acc[ai][bj][m][0], acc[ai][bj][m][1]};
                    if (type == 0 || type == 3) {
#pragma unroll
                        for (int n = 0; n < 2; ++n)
#pragma unroll
                            for (int e = 0; e < 4; ++e) v[n][e] = fast_silu(v[n][e]);
                    } else if (type == 1) {
#pragma unroll
                        for (int n = 0; n < 2; ++n)
#pragma unroll
                            for (int e = 0; e < 4; ++e) { const float l = lbv[bj][n][e];
                                const float k = (1.0f - l) * __builtin_amdgcn_rcpf(1.0f + __builtin_amdgcn_exp2f(1.4426950408889634f * v[n][e]));
                                v[n][e] = k < 0.5f ? k : k - 1.0f; }
                    }
                    __builtin_nontemporal_store(pack8(v[0], v[1]), (u32x4*)(rowp + (size_t)bj * HM_ROWS * 128)); } }
    }
};

struct EpiKV {
    static constexpr bool PERM = true, AFTER_DRAIN = false;
    bf16_t* KB; bf16_t* VB; const int* pos; const float* tab; float* KM;
    __device__ __forceinline__ void operator()(const f32x4 (&acc)[2][2][4][2], const Unit& u, int wr, int wc, int fr, int fq) const {
        const int type = u.pn >> 2;
        const int row0 = u.pm * BM + wr * 64 + fr, col0 = (u.pn & 3) * BM + wc * 32 + 8 * fq;
        if (type == 1) {
#pragma unroll
            for (int ai = 0; ai < 2; ++ai)
#pragma unroll
                for (int m = 0; m < 4; ++m) { bf16_t* rowp = VB + hm_base(u.pm, 2 * (u.pn & 3)) + (unsigned)((wr * 64 + fr + ai * HALF + m * 16) * 128 + 32 * wc + 8 * fq);
#pragma unroll
                    for (int bj = 0; bj < 2; ++bj) __builtin_nontemporal_store(pack8(acc[ai][bj][m][0], acc[ai][bj][m][1]), (u32x4*)(rowp + (size_t)bj * HM_ROWS * 128)); }
        } else {
            f32x4 cs[2][2];
#pragma unroll
            for (int bj = 0; bj < 2; ++bj)
#pragma unroll
                for (int n = 0; n < 2; ++n) cs[bj][n] = (f32x4){0.f, 0.f, 0.f, 0.f};
#pragma unroll
            for (int ai = 0; ai < 2; ++ai)
#pragma unroll
                for (int m = 0; m < 4; ++m) { const int row = row0 + ai * HALF + m * 16; int p = pos[row]; p = p < 0 ? 0 : (p > 4095 ? 4095 : p);
                    const float* tp = tab + ((size_t)p * 64 + 16 * wc + 4 * fq) * 2; const f32x4 t0 = *(const f32x4*)tp, t1 = *(const f32x4*)(tp + 4);
                    bf16_t* rowp = KB + hm_base(u.pm, 2 * (u.pn & 3)) + (unsigned)((wr * 64 + fr + ai * HALF + m * 16) * 128 + 32 * wc + 8 * fq);
#pragma unroll
                    for (int bj = 0; bj < 2; ++bj) { const f32x4 r0 = rope4(acc[ai][bj][m][0], t0), r1 = rope4(acc[ai][bj][m][1], t1);
                        cs[bj][0] += r0; cs[bj][1] += r1; __builtin_nontemporal_store(pack8(r0, r1), (u32x4*)(rowp + (size_t)bj * HM_ROWS * 128)); } }
#pragma unroll
            for (int bj = 0; bj < 2; ++bj)
#pragma unroll
                for (int n = 0; n < 2; ++n)
#pragma unroll
                    for (int e = 0; e < 4; ++e) { float s = cs[bj][n][e]; s += __shfl_xor(s, 1); s += __shfl_xor(s, 2); s += __shfl_xor(s, 4); s += __shfl_xor(s, 8); cs[bj][n][e] = s; }
            if (fr == 0) { const int b = u.pm >> 3, blk = u.pm & 7;
#pragma unroll
                for (int bj = 0; bj < 2; ++bj) { const int h = 2 * (u.pn & 3) + bj; float* kp = KM + ((size_t)(((b * 8 + h) * 8 + blk) * 2 + wr)) * 128 + 32 * wc + 8 * fq;
                    *(f32x4*)kp = cs[bj][0]; *(f32x4*)(kp + 4) = cs[bj][1]; } }
        }
    }
};

struct EpiQZ {
    static constexpr bool PERM = true, AFTER_DRAIN = false;
    bf16_t* QB; bf16_t* ZS; const int* pos; const float* tab; float qscale;
    __device__ __forceinline__ void operator()(const f32x4 (&acc)[2][2][4][2], const Unit& u, int wr, int wc, int fr, int fq) const {
        const int type = u.pn >> 2;
        const int row0 = u.pm * BM + wr * 64 + fr, col0 = (u.pn & 3) * BM + wc * 32 + 8 * fq;
        if (type == 1) {
#pragma unroll
            for (int ai = 0; ai < 2; ++ai)
#pragma unroll
                for (int m = 0; m < 4; ++m) { bf16_t* rowp = ZS + (size_t)(row0 + ai * HALF + m * 16) * LDC + col0;
#pragma unroll
                    for (int bj = 0; bj < 2; ++bj) { f32x4 v[2] = {acc[ai][bj][m][0], acc[ai][bj][m][1]};
#pragma unroll
                        for (int n = 0; n < 2; ++n)
#pragma unroll
                            for (int e = 0; e < 4; ++e) v[n][e] = fast_silu(v[n][e]);
                        *(u32x4*)(rowp + bj * HALF) = pack8(v[0], v[1]); } }
        } else {
#pragma unroll
            for (int ai = 0; ai < 2; ++ai)
#pragma unroll
                for (int m = 0; m < 4; ++m) { const int row = row0 + ai * HALF + m * 16; int p = pos[row]; p = p < 0 ? 0 : (p > 4095 ? 4095 : p);
                    const float* tp = tab + ((size_t)p * 64 + 16 * wc + 4 * fq) * 2; const f32x4 t0 = *(const f32x4*)tp * qscale, t1 = *(const f32x4*)(tp + 4) * qscale;
                    bf16_t* rowp = QB + (size_t)row * LDC + col0;
#pragma unroll
                    for (int bj = 0; bj < 2; ++bj) *(u32x4*)(rowp + bj * HALF) = pack8(rope4(acc[ai][bj][m][0], t0), rope4(acc[ai][bj][m][1], t1)); }
        }
    }
};
template <class Epi, class Sched, bool ALIGN_EPI = false, bool SP2 = false>
__device__ __forceinline__ void gemm_phase(PG8_LAS unsigned char* lds, const Gemm g, const Sched& S, const Epi& E) {
    int tid_ = threadIdx.x; asm volatile("" : "+v"(tid_));
    const int tid = tid_, wid = __builtin_amdgcn_readfirstlane(tid >> 6), lane = tid & 63, wr = wid >> 2, wc = wid & 3, fr = lane & 15, fq = lane >> 4;
    const int K = g.K, nt = K / BK;
    unsigned voffA[2], voffB[2];
#pragma unroll
    for (int i = 0; i < 2; ++i) { int R, C; stage_rc(tid * 16 + i * 8192, R, C); const int Rb = Epi::PERM ? ((R & ~31) + perm32(R & 31)) : R;
        voffA[i] = (unsigned)(R * K + C) * 2u; voffB[i] = (unsigned)(Rb * K + C) * 2u; }
    const size_t kstep = (size_t)(BK * 2);
    const size_t hstep = (size_t)HALF * K * 2;
    const size_t tstep = 2 * hstep;
    const unsigned ldsw = (unsigned)wid * 1024u;
    const int aoff = lds_byte(wr * 64 + fr, fq * 8), boff = lds_byte(wc * 32 + fr, fq * 8);
#define PG8_SA(b, h) (((b) * 2 + (h)) * HTB)
#define PG8_SB(b, h) ((4 + (b) * 2 + (h)) * HTB)
#define PG8_STAGE(bufoff, gbase, voff) do { _Pragma("unroll") for (int _i = 0; _i < 2; ++_i) \
        __builtin_amdgcn_global_load_lds((const unsigned*)((const char*)(gbase) + (voff)[_i]), (PG8_LAS unsigned*)(lds + (bufoff) + ldsw + _i * 8192), 16, 0, 0); } while (0)
#define PG8_LDA(dst, b, h) do { _Pragma("unroll") for (int m = 0; m < 4; ++m) _Pragma("unroll") for (int k = 0; k < 2; ++k) dst[m][k] = *(const PG8_LAS bf16x8*)(lds + PG8_SA(b, h) + aoff + m * 2048 + k * 1024); } while (0)
#define PG8_LDB(dst, b, h) do { _Pragma("unroll") for (int n = 0; n < 2; ++n) _Pragma("unroll") for (int k = 0; k < 2; ++k) dst[n][k] = *(const PG8_LAS bf16x8*)(lds + PG8_SB(b, h) + boff + n * 2048 + k * 1024); } while (0)
#define PG8_MMA(ai, bj, At, Bt) do { __builtin_amdgcn_s_setprio(1); _Pragma("unroll") for (int m = 0; m < 4; ++m) _Pragma("unroll") for (int n = 0; n < 2; ++n) _Pragma("unroll") for (int k = 0; k < 2; ++k) \
        acc[ai][bj][m][n] = __builtin_amdgcn_mfma_f32_16x16x32_bf16(Bt[n][k], At[m][k], acc[ai][bj][m][n], 0, 0, 0); __builtin_amdgcn_s_setprio(0); } while (0)
#define PG8_WAIT_V(n) asm volatile("s_waitcnt vmcnt(" #n ")" ::: "memory")
#define PG8_WAIT_L(n) asm volatile("s_waitcnt lgkmcnt(" #n ")" ::: "memory")
#define PG8_BAR __builtin_amdgcn_s_barrier()
#define PG8_SCHED __builtin_amdgcn_sched_barrier(0)
    Unit cur, nxt; int ui = 0;
    if (!S.next(0, cur)) return;
    f32x4 acc[2][2][4][2];
#pragma unroll
    for (int a = 0; a < 2; ++a)
#pragma unroll
        for (int b = 0; b < 2; ++b)
#pragma unroll
            for (int m = 0; m < 4; ++m)
#pragma unroll
                for (int n = 0; n < 2; ++n) acc[a][b][m][n] = (f32x4){0.f, 0.f, 0.f, 0.f};
    bf16x8 At[4][2], B0[2][2], B1[2][2];
    const char* cA = (const char*)g.A + (size_t)cur.pm * tstep; const char* cB = (const char*)g.Bt + (size_t)cur.pn * tstep;
    S.a_ready(cur);
    if constexpr (SP2) {
        PG8_STAGE(PG8_SB(0, 0), cB, voffB); PG8_STAGE(PG8_SB(0, 1), cB + hstep, voffB); PG8_STAGE(PG8_SA(0, 0), cA, voffA); PG8_STAGE(PG8_SA(0, 1), cA + hstep, voffA);
        if (wr == 1) PG8_BAR;
        PG8_WAIT_V(2); PG8_BAR;
        PG8_STAGE(PG8_SB(1, 0), cB + kstep, voffB); PG8_STAGE(PG8_SA(1, 0), cA + kstep, voffA); PG8_STAGE(PG8_SB(1, 1), cB + hstep + kstep, voffB);
        PG8_WAIT_V(6); PG8_BAR;
    } else {
        PG8_STAGE(PG8_SB(0, 0), cB, voffB); PG8_STAGE(PG8_SA(0, 0), cA, voffA); PG8_STAGE(PG8_SB(0, 1), cB + hstep, voffB); PG8_STAGE(PG8_SA(0, 1), cA + hstep, voffA);
        if (wr == 1) PG8_BAR;
        PG8_WAIT_V(4); PG8_BAR;
        PG8_STAGE(PG8_SB(1, 0), cB + kstep, voffB); PG8_STAGE(PG8_SA(1, 0), cA + kstep, voffA); PG8_STAGE(PG8_SB(1, 1), cB + hstep + kstep, voffB);
        PG8_WAIT_V(6); PG8_BAR;
    }
    for (;;) {
        const bool has_next = S.next(ui + 1, nxt);
        const char* nA = has_next ? (const char*)g.A + (size_t)nxt.pm * tstep : cA; const char* nB = has_next ? (const char*)g.Bt + (size_t)nxt.pn * tstep : cB;
        for (int t = 0; t < nt; t += 2) {
            const bool last = (t == nt - 2);
            const char* a1 = cA + (size_t)(t + 1) * kstep;
            const char* a2 = last ? nA : cA + (size_t)(t + 2) * kstep; const char* b2 = last ? nB : cB + (size_t)(t + 2) * kstep;
            const char* a3 = a2 + kstep; const char* b3 = b2 + kstep;
            if (last && has_next) S.a_ready(nxt);
            if constexpr (SP2) {
            PG8_LDB(B0, 0, 0); PG8_LDB(B1, 0, 1); PG8_SCHED; PG8_LDA(At, 0, 0); PG8_STAGE(PG8_SA(1, 1), a1 + hstep, voffA);
            PG8_WAIT_V(8); PG8_WAIT_L(0); PG8_BAR; PG8_MMA(0, 0, At, B0); PG8_MMA(0, 1, At, B1); PG8_BAR; PG8_SCHED;
            PG8_LDA(At, 0, 1); PG8_STAGE(PG8_SB(0, 0), b2, voffB); PG8_STAGE(PG8_SB(0, 1), b2 + hstep, voffB); PG8_STAGE(PG8_SA(0, 0), a2, voffA);
            PG8_WAIT_V(8); PG8_WAIT_L(0); PG8_BAR; PG8_MMA(1, 0, At, B0); PG8_MMA(1, 1, At, B1); PG8_BAR; PG8_SCHED;
            PG8_LDB(B0, 1, 0); PG8_LDB(B1, 1, 1); PG8_SCHED; PG8_LDA(At, 1, 0); PG8_STAGE(PG8_SA(0, 1), a2 + hstep, voffA);
            PG8_WAIT_V(8); PG8_WAIT_L(0); PG8_BAR; PG8_MMA(0, 0, At, B0); PG8_MMA(0, 1, At, B1); PG8_BAR; PG8_SCHED;
            PG8_LDA(At, 1, 1); PG8_STAGE(PG8_SB(1, 0), b3, voffB); PG8_STAGE(PG8_SB(1, 1), b3 + hstep, voffB); PG8_STAGE(PG8_SA(1, 0), a3, voffA);
            PG8_WAIT_V(8); PG8_WAIT_L(0); PG8_BAR; PG8_MMA(1, 0, At, B0); PG8_MMA(1, 1, At, B1); PG8_BAR; PG8_SCHED;
            } else {
            PG8_LDB(B0, 0, 0); PG8_SCHED; PG8_LDA(At, 0, 0); PG8_STAGE(PG8_SA(1, 1), a1 + hstep, voffA);
            PG8_WAIT_L(8); PG8_BAR; PG8_WAIT_L(0); PG8_MMA(0, 0, At, B0); PG8_BAR; PG8_SCHED;
            PG8_LDB(B1, 0, 1); PG8_STAGE(PG8_SB(0, 0), b2, voffB);
            PG8_BAR; PG8_WAIT_L(0); PG8_MMA(0, 1, At, B1); PG8_BAR;
            PG8_LDA(At, 0, 1); PG8_STAGE(PG8_SA(0, 0), a2, voffA);
            PG8_BAR; PG8_WAIT_L(0); PG8_MMA(1, 0, At, B0); PG8_BAR; PG8_SCHED;
            PG8_STAGE(PG8_SB(0, 1), b2 + hstep, voffB);
            PG8_WAIT_V(6); PG8_BAR; PG8_MMA(1, 1, At, B1); PG8_BAR;
            PG8_LDB(B0, 1, 0); PG8_SCHED; PG8_LDA(At, 1, 0); PG8_STAGE(PG8_SA(0, 1), a2 + hstep, voffA);
            PG8_WAIT_L(8); PG8_BAR; PG8_WAIT_L(0); PG8_MMA(0, 0, At, B0); PG8_BAR; PG8_SCHED;
            PG8_LDB(B1, 1, 1); PG8_STAGE(PG8_SB(1, 0), b3, voffB);
            PG8_BAR; PG8_WAIT_L(0); PG8_MMA(0, 1, At, B1); PG8_BAR;
            PG8_LDA(At, 1, 1); PG8_STAGE(PG8_SA(1, 0), a3, voffA);
            PG8_BAR; PG8_WAIT_L(0); PG8_MMA(1, 0, At, B0); PG8_BAR; PG8_SCHED;
            PG8_STAGE(PG8_SB(1, 1), b3 + hstep, voffB);
            PG8_WAIT_V(6); PG8_BAR; PG8_MMA(1, 1, At, B1); PG8_BAR;
            }
        }
        if constexpr (ALIGN_EPI) { if (wr == 0) PG8_BAR; }
        if constexpr (!Epi::AFTER_DRAIN) { E(acc, cur, wr, wc, fr, fq); S.done(cur); }
        if (!has_next) break;
#pragma unroll
        for (int a = 0; a < 2; ++a)
#pragma unroll
            for (int b = 0; b < 2; ++b)
#pragma unroll
                for (int m = 0; m < 4; ++m)
#pragma unroll
                    for (int n = 0; n < 2; ++n) acc[a][b][m][n] = (f32x4){0.f, 0.f, 0.f, 0.f};
        cur = nxt; cA = nA; cB = nB; ++ui;
        if constexpr (ALIGN_EPI) { if (wr == 1) PG8_BAR; }
    }
    PG8_WAIT_V(0);
    if constexpr (!ALIGN_EPI) { if (wr == 0) PG8_BAR; }
    PG8_BAR;
    if constexpr (Epi::AFTER_DRAIN) { E.fused(acc, cur, wr, wc, fr, fq, lds, wid, lane); S.done(cur); }
#undef PG8_SA
#undef PG8_SB
#undef PG8_STAGE
#undef PG8_LDA
#undef PG8_LDB
#undef PG8_MMA
#undef PG8_WAIT_V
#undef PG8_WAIT_L
#undef PG8_BAR
#undef PG8_SCHED
}
}

constexpr int NWAVES = 8;
constexpr int BATCH = 32, SEQ = 2048, DM = 1024, M = BATCH * SEQ;
constexpr int NH = 8, HD = 128;
constexpr float NORM_EPS = 1e-6f;
constexpr float LOG2E = 1.4426950408889634f;
constexpr float QSCALE = 0.08838834764831845f * 1.4426950408889634f;
constexpr int NPH = 10;
#ifndef MK_N_LAUNCHES
#define MK_N_LAUNCHES 1
#endif
constexpr int N_LAUNCHES = MK_N_LAUNCHES;

constexpr size_t MiB = 1u << 20;
constexpr size_t WS_CTL = 0, CTL_ZERO_BYTES = 32768;
constexpr size_t WS_WIN0 = 2 * MiB, WS_WOUT0 = 10 * MiB, WS_WKV = 12 * MiB, WS_WIN1 = 16 * MiB, WS_WOUT1 = 20 * MiB;
constexpr size_t WS_MOD = 22 * MiB;
constexpr size_t WS_LB = 23 * MiB;
constexpr size_t WS_TAB = 24 * MiB;
constexpr size_t WS_KM = 26 * MiB;
constexpr size_t WS_ACT = 32 * MiB, SLOT = 130 * MiB;
constexpr size_t WS_S0 = WS_ACT, WS_S1 = WS_ACT + SLOT, WS_S2 = WS_ACT + 2 * SLOT, WS_S3 = WS_ACT + 3 * SLOT, WS_S4 = WS_ACT + 4 * SLOT, WS_S5 = WS_ACT + 5 * SLOT, WS_S6 = WS_ACT + 6 * SLOT;
constexpr size_t WS_END = WS_ACT + 7 * SLOT;
constexpr int CW_BAR = 4096;

constexpr int RING_BYTES = 131072;
constexpr int LDSCTL_OFF = 143360, MISC_OFF = LDSCTL_OFF + 320;
constexpr int LDS_BYTES = 147456;

#define GAS __attribute__((address_space(1)))
#define LAS __attribute__((address_space(3)))
typedef unsigned short bf16;
typedef unsigned u32x4 __attribute__((ext_vector_type(4)));
typedef unsigned u32x2 __attribute__((ext_vector_type(2)));
typedef float f32x4 __attribute__((ext_vector_type(4)));
typedef float f32x2 __attribute__((ext_vector_type(2)));
typedef short bf16x8 __attribute__((ext_vector_type(8)));
typedef short s16x4 __attribute__((ext_vector_type(4)));
typedef GAS unsigned gu32;
#define RLX_AGENT __ATOMIC_RELAXED, __HIP_MEMORY_SCOPE_AGENT
#define MFMA16(a, b, c) __builtin_amdgcn_mfma_f32_16x16x32_bf16((a), (b), (c), 0, 0, 0)
__device__ __forceinline__ unsigned pk2(float lo, float hi) { return pg8::cvt_pk_bf16(lo, hi); }
__device__ __forceinline__ float bflo(unsigned w) { return __uint_as_float(w << 16); }
__device__ __forceinline__ float bfhi(unsigned w) { return __uint_as_float(w & 0xffff0000u); }
__device__ __forceinline__ float bf2f(bf16 h) { return __uint_as_float((unsigned)h << 16); }
__device__ __forceinline__ bf16 f2bf(float f) { return (bf16)(pk2(f, 0.f) & 0xffffu); }
__device__ __forceinline__ float ex2(float x) { return __builtin_amdgcn_exp2f(x); }
template <int CTRL> __device__ __forceinline__ float dppf(float x) { return __builtin_bit_cast(float, __builtin_amdgcn_mov_dpp(__builtin_bit_cast(int, x), CTRL, 0xf, 0xf, true)); }
__device__ __forceinline__ float wave_sum(float v) {
    v += dppf<0xB1>(v); v += dppf<0x4E>(v); v += dppf<0x141>(v); v += dppf<0x140>(v);
    { auto s = __builtin_amdgcn_permlane16_swap(__float_as_uint(v), __float_as_uint(v), false, false); v = __uint_as_float(s[0]) + __uint_as_float(s[1]); }
    { auto t = __builtin_amdgcn_permlane32_swap(__float_as_uint(v), __float_as_uint(v), false, false); v = __uint_as_float(t[0]) + __uint_as_float(t[1]); }
    return v;
}

#define XB_TMO      128
#define XB_XCNT(j)  (256  + 64 * (j))
#define XB_XSUB(j)  (1280 + 64 * (j))
#define XB_XGEN(j)  (2304 + 64 * (j))
#define XB_TOP      3328
#define XB_TOPGEN   3392
#define XCD_BAR_WORDS 3456
#define XB_SPIN_CAP (1u << 18)

__device__ __forceinline__ unsigned xb_ld(unsigned* p)              { return __hip_atomic_load(p, __ATOMIC_RELAXED, __HIP_MEMORY_SCOPE_AGENT); }
__device__ __forceinline__ unsigned xb_add(unsigned* p, unsigned v) { return __hip_atomic_fetch_add(p, v, __ATOMIC_RELAXED, __HIP_MEMORY_SCOPE_AGENT); }
__device__ __forceinline__ unsigned xb_xcc_id() { return (unsigned)__builtin_amdgcn_s_getreg((3 << 11) | 20) & 0xFu; }
#define XB_SPIN(cond, bar) do { unsigned _sp = 0; while (cond) { __builtin_amdgcn_s_sleep(1); \
    if ((++_sp & 255u) == 0u) { if (xb_ld(&(bar)[XB_TMO])) break; if (_sp > XB_SPIN_CAP) { atomicAdd(&(bar)[XB_TMO], 1u); break; } } } } while (0)

struct XcdBarrier { unsigned* bar; unsigned x; volatile LAS unsigned* st; };
__device__ __forceinline__ XcdBarrier xcd_barrier_post(unsigned* bar, volatile LAS unsigned* st) {
    XcdBarrier b; b.bar = bar; b.x = xb_xcc_id(); b.st = st;
    if (threadIdx.x == 0) (void)xb_add(&bar[XB_XCNT(b.x)], 1u);
    return b;
}
__device__ __forceinline__ void xcd_barrier_complete(unsigned* bar, unsigned x, unsigned& nloc, unsigned& nx) {
    const unsigned G = gridDim.x * gridDim.y * gridDim.z;
    unsigned sum, cnt, mine, sp = 0u;
    for (;;) {
        sum = 0u; cnt = 0u; mine = 0u;
#pragma unroll
        for (unsigned j = 0; j < 16; ++j) { const unsigned c = xb_ld(&bar[XB_XCNT(j)]); sum += c; cnt += (c > 0u) ? 1u : 0u; mine = (j == x) ? c : mine; }
        if (sum == G) break;
        __builtin_amdgcn_s_sleep(1);
        if ((++sp & 255u) == 0u) { if (xb_ld(&bar[XB_TMO])) break; if (sp > XB_SPIN_CAP) { atomicAdd(&bar[XB_TMO], 1u); break; } }
    }
    nloc = mine > 0u ? mine : 1u; nx = cnt > 0u ? cnt : 1u;
}
__device__ __forceinline__ void xcd_barrier(const XcdBarrier& b) {
    asm volatile("s_waitcnt vmcnt(0)" ::: "memory");
    __syncthreads();
    if (threadIdx.x == 0) {
        unsigned* bar = b.bar;
        __builtin_amdgcn_s_waitcnt(0);
        unsigned nloc = b.st[0], nx = b.st[1];
        if (nloc == 0u) { xcd_barrier_complete(bar, b.x, nloc, nx); b.st[0] = nloc; b.st[1] = nx; }
        const unsigned old = xb_add(&bar[XB_XSUB(b.x)], 1u);
        const unsigned gen = old / nloc;
        if (old + 1u == (gen + 1u) * nloc) {
            __builtin_amdgcn_fence(__ATOMIC_RELEASE, "agent");
            asm volatile("s_waitcnt vmcnt(0)" ::: "memory");
            const unsigned og = xb_add(&bar[XB_TOP], 1u);
            const unsigned tg = og / nx;
            if (og + 1u == (tg + 1u) * nx) xb_add(&bar[XB_TOPGEN], 1u);
            else XB_SPIN(xb_ld(&bar[XB_TOPGEN]) == tg, bar);
            __builtin_amdgcn_fence(__ATOMIC_ACQUIRE, "agent");
            xb_add(&bar[XB_XGEN(b.x)], 1u);
            asm volatile("s_waitcnt vmcnt(0)" ::: "memory");
        } else {
            XB_SPIN(xb_ld(&bar[XB_XGEN(b.x)]) == gen, bar);
            __builtin_amdgcn_fence(__ATOMIC_ACQUIRE, "agent");
            asm volatile("s_waitcnt vmcnt(0)" ::: "memory");
        }
    }
    __syncthreads();
}

struct Frame {
    LAS unsigned char* lds;
    int tid, lane, wave;
    int vcu, G;
    const float *x, *c, *mod_w, *mod_b, *pre_g, *post_g, *a_w_in, *a_w_out, *a_gn, *a_lb, *kv_g, *w_kv, *b_w_in, *b_w_out;
    const int* pos;
    float* out;
    bf16 *Win0, *Wout0, *Wkv, *Win1, *Wout1;
    float *MOD, *LB, *TAB, *KM;
    bf16 *S0, *S1, *S2, *S3, *S4, *S5, *S6;
};

__device__ __forceinline__ int rope_row(int n) { const int h = n >> 7, d = n & 127; return (h << 7) + ((d & 63) << 1) + (d >> 6); }
__device__ __forceinline__ void p0_transpose_item(const float* W, int K, int N, bf16* WT, int perm_cols, LAS float* scr, int item, int lane) {
    const int nblk = N / 32, kb = item / nblk, nb = item % nblk, k0 = 64 * kb, n0 = 32 * nb;
#pragma unroll 8
    for (int i = 0; i < 32; ++i) { const int kk = 2 * i + (lane >> 5); scr[kk * 33 + (lane & 31)] = W[(size_t)(k0 + kk) * N + n0 + (lane & 31)]; }
    asm volatile("s_waitcnt lgkmcnt(0)" ::: "memory");
    const int c = lane & 7;
#pragma unroll
    for (int j = 0; j < 4; ++j) { const int n = (lane >> 3) + 8 * j; const LAS float* s = scr + (8 * c) * 33 + n;
        u32x4 o; o.x = pk2(s[0 * 33], s[1 * 33]); o.y = pk2(s[2 * 33], s[3 * 33]); o.z = pk2(s[4 * 33], s[5 * 33]); o.w = pk2(s[6 * 33], s[7 * 33]);
        const int nn = n0 + n, dr = nn < perm_cols ? rope_row(nn) : nn;
        *(GAS u32x4*)(WT + (size_t)dr * K + k0 + 8 * c) = o; }
    asm volatile("s_waitcnt lgkmcnt(0)" ::: "memory");
}
__device__ __forceinline__ void rope_cs(int pos, int i, float& co, float& si) {
    double inv = 1.0, bs = 0.8659643233600653;
    for (int e = i; e > 0; e >>= 1) { if (e & 1) inv *= bs; bs *= bs; }
    const float ang = (float)pos * (float)inv;
    const double x = (double)ang, kq = __builtin_rint(x * 0.6366197723675814);
    double r = __builtin_fma(-kq, 1.5707963267948966, x); r = __builtin_fma(-kq, 6.123233995736766e-17, r);
    const double r2 = r * r;
    const double sp = r * (1.0 + r2 * (-1.0 / 6 + r2 * (1.0 / 120 + r2 * (-1.0 / 5040 + r2 * (1.0 / 362880 + r2 * (-1.0 / 39916800 + r2 * (1.0 / 6227020800.0)))))));
    const double cp = 1.0 + r2 * (-0.5 + r2 * (1.0 / 24 + r2 * (-1.0 / 720 + r2 * (1.0 / 40320 + r2 * (-1.0 / 3628800 + r2 * (1.0 / 479001600 + r2 * (-1.0 / 87178291200.0)))))));
    const int q = ((int)kq) & 3;
    const double cc = (q == 0) ? cp : (q == 1) ? -sp : (q == 2) ? -cp : sp;
    const double ss = (q == 0) ? sp : (q == 1) ? cp : (q == 2) ? -sp : -cp;
    co = (float)cc; si = (float)ss;
}
__device__ __forceinline__ void p0_modulation_item(Frame& F, int item) {
    const int l = item / 96, n0 = (item % 96) * 32, tid = F.tid;
    LAS float* sc = (LAS float*)F.lds;
#pragma unroll 1
    for (int base = 0; base < 32768; base += 512 * 16) {
        float v[16];
#pragma unroll
        for (int u = 0; u < 16; ++u) v[u] = F.c[base + u * 512 + tid];
#pragma unroll
        for (int u = 0; u < 16; ++u) { const int idx = base + u * 512 + tid, b = idx >> 10, k = idx & 1023; sc[k * 32 + b] = v[u] / (1.0f + __expf(-v[u])); }
    }
    __syncthreads();
    const int col = tid & 31, ks = tid >> 5;
    float acc[32];
#pragma unroll
    for (int b = 0; b < 32; ++b) acc[b] = 0.f;
    const float* w = F.mod_w + (size_t)l * 1024 * 3072 + n0 + col;
#pragma unroll 1
    for (int i0 = 0; i0 < 64; i0 += 16) {
        float wv[16];
#pragma unroll
        for (int u = 0; u < 16; ++u) wv[u] = w[(size_t)(ks + 16 * (i0 + u)) * 3072];
#pragma unroll
        for (int u = 0; u < 16; ++u) { const int k = ks + 16 * (i0 + u); const LAS f32x4* s4 = (const LAS f32x4*)(sc + k * 32);
#pragma unroll
            for (int b4 = 0; b4 < 8; ++b4) { const f32x4 sv = s4[b4]; acc[4 * b4 + 0] += sv[0] * wv[u]; acc[4 * b4 + 1] += sv[1] * wv[u]; acc[4 * b4 + 2] += sv[2] * wv[u]; acc[4 * b4 + 3] += sv[3] * wv[u]; } }
    }
    __syncthreads();
    LAS float* red = sc;
#pragma unroll
    for (int b = 0; b < 32; ++b) red[(ks * 32 + b) * 32 + col] = acc[b];
    __syncthreads();
    for (int o = tid; o < 1024; o += 512) { const int b = o >> 5, cc = o & 31; float s = 0.f;
#pragma unroll
        for (int k2 = 0; k2 < 16; ++k2) s += red[(k2 * 32 + b) * 32 + cc];
        F.MOD[(size_t)(l * 32 + b) * 3072 + n0 + cc] = s + F.mod_b[l * 3072 + n0 + cc]; }
    __syncthreads();
}
__device__ __forceinline__ void p0_prologue(Frame& F) {
    for (int it = F.vcu; it < 192; it += F.G) p0_modulation_item(F, it);
    const int gt = F.vcu * 512 + F.tid, NGT = F.G * 512;
    for (int d = gt; d < 1024; d += NGT) F.LB[d] = 1.0f / (1.0f + __expf(F.a_lb[1024 + d] - F.a_lb[d]));
    for (int idx = gt; idx < 4096 * 64; idx += NGT) { float co, si; rope_cs(idx >> 6, idx & 63, co, si); *(f32x2*)(F.TAB + (size_t)idx * 2) = (f32x2){co, si}; }
    LAS float* scr = (LAS float*)(F.lds + F.wave * 16384);
    const int gw = F.vcu * NWAVES + F.wave, NGW = F.G * NWAVES;
    constexpr int I_IN0 = 16 * 128, I_OUT = 16 * 32, I_KV = 16 * 64;
    constexpr int NITEMS = I_IN0 + 2 * I_OUT + 2 * I_KV;
    for (int it = gw; it < NITEMS; it += NGW) {
        int r = it;
        if (r < I_IN0) { p0_transpose_item(F.a_w_in, 1024, 4096, F.Win0, 0, scr, r, F.lane); continue; } r -= I_IN0;
        if (r < I_OUT) { p0_transpose_item(F.a_w_out, 1024, 1024, F.Wout0, 0, scr, r, F.lane); continue; } r -= I_OUT;
        if (r < I_KV) { p0_transpose_item(F.w_kv, 1024, 2048, F.Wkv, 1024, scr, r, F.lane); continue; } r -= I_KV;
        if (r < I_KV) { p0_transpose_item(F.b_w_in, 1024, 2048, F.Win1, 1024, scr, r, F.lane); continue; } r -= I_KV;
        p0_transpose_item(F.b_w_out, 1024, 1024, F.Wout1, 0, scr, r, F.lane);
    }
}

constexpr int RS = 1;
__device__ __forceinline__ void p1_modnorm(Frame& F) {
    const int gw = F.vcu * NWAVES + F.wave, NGW = F.G * NWAVES, lane = F.lane;
    const int nit = (M - gw + NGW - 1) / NGW;
    f32x4 G[4];
#pragma unroll
    for (int j = 0; j < 4; ++j) G[j] = *(const f32x4*)(F.pre_g + 4 * lane + 256 * j);
    f32x4 xr[4][4], sc[4], sh[4], scn[4], shn[4];
#define P1_ROW(it_) ((size_t)(nit - 1 - (it_)) * NGW + gw)
#define P1_XLOAD(slot, it_) do { const GAS f32x4* xp_ = (const GAS f32x4*)(F.x + P1_ROW(it_) * DM) + lane; _Pragma("unroll") for (int j = 0; j < 4; ++j) xr[slot][j] = __builtin_nontemporal_load(xp_ + 64 * j); } while (0)
#define P1_CLOAD(SC, SH, it_) do { const float* mod_ = F.MOD + (size_t)(P1_ROW(it_) / SEQ) * 3072 + 4 * lane; _Pragma("unroll") for (int j = 0; j < 4; ++j) { SC[j] = *(const f32x4*)(mod_ + 1024 + 256 * j); SH[j] = *(const f32x4*)(mod_ + 256 * j); } } while (0)
#define P1_STEP(slot, it_) do { if ((it_) < nit) { \
        if ((it_) + 1 < nit) P1_CLOAD(scn, shn, (it_) + 1); \
        float ss = 0.f; _Pragma("unroll") for (int j = 0; j < 4; ++j) { const f32x4 v = xr[slot][j]; ss += (v[0] * v[0] + v[1] * v[1]) + (v[2] * v[2] + v[3] * v[3]); } \
        const float rstd = 1.0f / sqrtf(wave_sum(ss) * (1.0f / DM) + NORM_EPS); \
        GAS u32x2* o8 = (GAS u32x2*)(F.S0 + P1_ROW(it_) * DM) + lane; \
        _Pragma("unroll") for (int j = 0; j < 4; ++j) { const f32x4 u = xr[slot][j] * rstd * (G[j] * (1.0f + sc[j])) + sh[j]; o8[64 * j] = (u32x2){pk2(u[0], u[1]), pk2(u[2], u[3])}; } \
        if ((it_) + 4 < nit) P1_XLOAD(slot, (it_) + 4); \
        _Pragma("unroll") for (int j = 0; j < 4; ++j) { sc[j] = scn[j]; sh[j] = shn[j]; } } } while (0)
    if (nit > 0) { P1_CLOAD(sc, sh, 0); }
#pragma unroll
    for (int q = 0; q < 4; ++q) if (q < nit) P1_XLOAD(q, q);
#pragma unroll 1
    for (int it0 = 0; it0 < nit; it0 += 4) { P1_STEP(0, it0); P1_STEP(1, it0 + 1); P1_STEP(2, it0 + 2); P1_STEP(3, it0 + 3); }
#undef P1_XLOAD
#undef P1_ROW
#undef P1_CLOAD
#undef P1_STEP
}
__device__ __forceinline__ void p5_mid(Frame& F) {
    const int gw = F.vcu * NWAVES + F.wave, NGW = F.G * NWAVES, lane = F.lane;
    for (int rb = gw; rb < M / 32; rb += NGW) {
        const int row0 = rb * 32, b = row0 / SEQ;
        const float* mod0 = F.MOD + (size_t)b * 3072; const float* mod1 = F.MOD + (size_t)(32 + b) * 3072;
        f32x4 G0[4], A1[4], B1[4], KG[4];
#pragma unroll
        for (int j = 0; j < 4; ++j) { const int c = 4 * lane + 256 * j;
            G0[j] = *(const f32x4*)(mod0 + 2048 + c) * *(const f32x4*)(F.post_g + c);
            A1[j] = *(const f32x4*)(F.pre_g + 1024 + c) * (1.0f + *(const f32x4*)(mod1 + 1024 + c)); B1[j] = *(const f32x4*)(mod1 + c); KG[j] = *(const f32x4*)(F.kv_g + c); }
        const GAS f32x4* xb = (const GAS f32x4*)(F.x + (size_t)row0 * DM) + lane; const GAS u32x2* yb = (const GAS u32x2*)(F.S6 + (size_t)row0 * DM) + lane;
        f32x4 cx[2][4], nx[2][4]; u32x2 cy[2][4], ny[2][4];
#pragma unroll
        for (int q = 0; q < 2; ++q)
#pragma unroll
            for (int j = 0; j < 4; ++j) { cx[q][j] = __builtin_nontemporal_load(xb + (size_t)(RS * q) * (DM / 4) + 64 * j); cy[q][j] = yb[(size_t)(RS * q) * (DM / 4) + 64 * j]; }
#pragma unroll 1
        for (int r = 0; r < 32; r += 2) {
            if (r + 2 < 32) {
#pragma unroll
                for (int q = 0; q < 2; ++q)
#pragma unroll
                    for (int j = 0; j < 4; ++j) { nx[q][j] = __builtin_nontemporal_load(xb + (size_t)(RS * (r + 2 + q)) * (DM / 4) + 64 * j); ny[q][j] = yb[(size_t)(RS * (r + 2 + q)) * (DM / 4) + 64 * j]; }
            }
#pragma unroll
            for (int q = 0; q < 2; ++q) {
                const size_t ro = (size_t)(row0 + RS * (r + q)) * DM;
                f32x4 v[4], y[4]; float ss = 0.f;
#pragma unroll
                for (int j = 0; j < 4; ++j) { v[j] = cx[q][j]; const u32x2 yw = cy[q][j]; y[j] = (f32x4){bflo(yw.x), bfhi(yw.x), bflo(yw.y), bfhi(yw.y)};
                    ss += (y[j][0] * y[j][0] + y[j][1] * y[j][1]) + (y[j][2] * y[j][2] + y[j][3] * y[j][3]); }
                const float rstd = 1.0f / sqrtf(wave_sum(ss) * (1.0f / DM) + NORM_EPS);
                float s2 = 0.f;
                GAS u32x2* ho = (GAS u32x2*)(F.out + ro) + lane;
#pragma unroll
                for (int j = 0; j < 4; ++j) { v[j] = v[j] + G0[j] * (y[j] * rstd); __builtin_nontemporal_store((u32x2){pk2(v[j][0], v[j][1]), pk2(v[j][2], v[j][3])}, ho + 64 * j); s2 += (v[j][0] * v[j][0] + v[j][1] * v[j][1]) + (v[j][2] * v[j][2] + v[j][3] * v[j][3]); }
                const float rstd1 = 1.0f / sqrtf(wave_sum(s2) * (1.0f / DM) + NORM_EPS);
                GAS u32x2* uo = (GAS u32x2*)(F.S0 + ro) + lane; GAS u32x2* ko = (GAS u32x2*)(F.S1 + ro) + lane;
#pragma unroll
                for (int j = 0; j < 4; ++j) { const f32x4 hn = v[j] * rstd1; const f32x4 u = hn * A1[j] + B1[j], k = hn * KG[j];
                    uo[64 * j] = (u32x2){pk2(u[0], u[1]), pk2(u[2], u[3])}; ko[64 * j] = (u32x2){pk2(k[0], k[1]), pk2(k[2], k[3])}; }
            }
#pragma unroll
            for (int q = 0; q < 2; ++q)
#pragma unroll
                for (int j = 0; j < 4; ++j) { cx[q][j] = nx[q][j]; cy[q][j] = ny[q][j]; }
        }
    }
}
__device__ __forceinline__ void p9_final(Frame& F) {
    const int gw = F.vcu * NWAVES + F.wave, NGW = F.G * NWAVES, lane = F.lane;
    for (int rb = gw; rb < M / 32; rb += NGW) {
        const int row0 = rb * 32, b = row0 / SEQ;
        const float* mod1 = F.MOD + (size_t)(32 + b) * 3072;
        f32x4 G1[4];
#pragma unroll
        for (int j = 0; j < 4; ++j) { const int c = 4 * lane + 256 * j; G1[j] = *(const f32x4*)(mod1 + 2048 + c) * *(const f32x4*)(F.post_g + 1024 + c); }
        GAS f32x4* hb = (GAS f32x4*)(F.out + (size_t)row0 * DM) + lane; const GAS u32x2* yb = (const GAS u32x2*)(F.S0 + (size_t)row0 * DM) + lane;
        const GAS u32x2* hq = (const GAS u32x2*)(F.out + (size_t)row0 * DM) + lane;
        u32x2 ch[2][4], nh[2][4]; u32x2 cy[2][4], ny[2][4];
#pragma unroll
        for (int q = 0; q < 2; ++q)
#pragma unroll
            for (int j = 0; j < 4; ++j) { ch[q][j] = hq[(size_t)(RS * q) * (DM / 2) + 64 * j]; cy[q][j] = yb[(size_t)(RS * q) * (DM / 4) + 64 * j]; }
#pragma unroll 1
        for (int r = 0; r < 32; r += 2) {
            if (r + 2 < 32) {
#pragma unroll
                for (int q = 0; q < 2; ++q)
#pragma unroll
                    for (int j = 0; j < 4; ++j) { nh[q][j] = hq[(size_t)(RS * (r + 2 + q)) * (DM / 2) + 64 * j]; ny[q][j] = yb[(size_t)(RS * (r + 2 + q)) * (DM / 4) + 64 * j]; }
            }
#pragma unroll
            for (int q = 0; q < 2; ++q) {
                f32x4 y[4]; float ss = 0.f;
#pragma unroll
                for (int j = 0; j < 4; ++j) { const u32x2 yw = cy[q][j]; y[j] = (f32x4){bflo(yw.x), bfhi(yw.x), bflo(yw.y), bfhi(yw.y)};
                    ss += (y[j][0] * y[j][0] + y[j][1] * y[j][1]) + (y[j][2] * y[j][2] + y[j][3] * y[j][3]); }
                const float rstd = 1.0f / sqrtf(wave_sum(ss) * (1.0f / DM) + NORM_EPS);
#pragma unroll
                for (int j = 0; j < 4; ++j) { const u32x2 hw = ch[q][j]; const f32x4 hv = (f32x4){bflo(hw.x), bfhi(hw.x), bflo(hw.y), bfhi(hw.y)}; __builtin_nontemporal_store(hv + G1[j] * (y[j] * rstd), hb + (size_t)(RS * (r + q)) * (DM / 4) + 64 * j); }
            }
#pragma unroll
            for (int q = 0; q < 2; ++q)
#pragma unroll
                for (int j = 0; j < 4; ++j) { ch[q][j] = nh[q][j]; cy[q][j] = ny[q][j]; }
        }
    }
}


__device__ __forceinline__ void p3_recurrence3(Frame& F) {
    LAS unsigned char* L = F.lds;
    constexpr int SET = 38400, O_QH = 0, O_KH = 8704, O_KLT = 17408, O_VT = 27648, O_EBL = 37888;
    constexpr int O_ATT = 2 * SET, O_PART = O_ATT + 2560, O_OB = O_PART + 4096;
    const int tid = F.tid, lane = F.lane, w = F.wave, g = lane >> 4, c16 = lane & 15;
    const bf16* QS = F.S1; const bf16* LF = F.S2; const bf16* VV = F.S3; const bf16* GS = F.S4; bf16* O0 = F.S5;
    const f32x4 ZERO4 = (f32x4){0.f, 0.f, 0.f, 0.f};
    const int dp = tid & 63, tq = tid >> 6;
    const int pd = (((2 * dp) & ~31) | ((((2 * dp) >> 2) & 3) << 3) | ((((2 * dp) >> 4) & 1) << 2) | ((2 * dp) & 3)) * 2;
    for (int bh = F.vcu; bh < BATCH * NH; bh += F.G) {
        const int b = bh >> 3, h = bh & 7;
        const size_t rbase = (size_t)b * SEQ;
        f32x4 S[8];
#pragma unroll
        for (int dt = 0; dt < 8; ++dt) S[dt] = ZERO4;
        const size_t hbase = (size_t)bh * pg8::HM_ROWS * HD;
        const bf16* qs_u = QS + hbase; const bf16* lf_u = LF + hbase; const bf16* vv_u = VV + hbase; const bf16* gs_u = GS + hbase; bf16* o0_u = O0 + rbase * DM + h * HD;
        const unsigned lo0 = (unsigned)((4 * tq) * HD + 2 * dp);
        const unsigned go0 = (unsigned)((4 * w + (lane >> 4)) * DM + (lane & 15) * 8);
        const unsigned gi0 = (unsigned)((4 * w + (lane >> 4)) * HD + (lane & 15) * 8);
        const f32x4 gn0 = *(const f32x4*)(F.a_gn + 8 * (lane & 15)), gn1 = *(const f32x4*)(F.a_gn + 8 * (lane & 15) + 4);
        unsigned rq[4], rl[4], rv[4], nq[4], nl[4], nv[4]; u32x4 gsr, gsn = (u32x4){0u, 0u, 0u, 0u};
        float kk0[4], kk1[4], cs0[4], cs1[4];
#define R3_LOAD(c, Q, Lq, V) do { const unsigned cx_ = (unsigned)((c) * 32 * HD) + lo0; _Pragma("unroll") for (int i_ = 0; i_ < 4; ++i_) { \
        Q[i_] = __builtin_nontemporal_load((const GAS unsigned*)(qs_u + (cx_ + i_ * HD))); Lq[i_] = __builtin_nontemporal_load((const GAS unsigned*)(lf_u + (cx_ + i_ * HD))); V[i_] = __builtin_nontemporal_load((const GAS unsigned*)(vv_u + (cx_ + i_ * HD))); } } while (0)
#define R3_ROT() do { _Pragma("unroll") for (int i_ = 0; i_ < 4; ++i_) { rq[i_] = nq[i_]; rl[i_] = nl[i_]; rv[i_] = nv[i_]; } } while (0)
#define R3_WALK() do { float r0_ = 1.f, r1_ = 1.f; _Pragma("unroll") for (int i_ = 0; i_ < 4; ++i_) { const float a0 = bflo(rl[i_]), a1 = bfhi(rl[i_]); \
        const float f0 = a0 >= 0.f ? 1.0f - a0 : -a0, f1 = a1 >= 0.f ? 1.0f - a1 : -a1; kk0[i_] = a0 >= 0.f ? a0 : 1.0f + a0; kk1[i_] = a1 >= 0.f ? a1 : 1.0f + a1; \
        r0_ *= f0; r1_ *= f1; cs0[i_] = r0_; cs1[i_] = r1_; } *(LAS f32x2*)(L + O_PART + (tq * 128 + 2 * dp) * 4) = (f32x2){r0_, r1_}; } while (0)
#define R3_PREP(set) do { LAS unsigned char* B_ = L + (set) * SET; f32x2 pre = (f32x2){1.f, 1.f}, tot = (f32x2){1.f, 1.f}; \
        _Pragma("unroll") for (int p_ = 0; p_ < 8; ++p_) { const f32x2 v_ = *(const LAS f32x2*)(L + O_PART + (p_ * 128 + 2 * dp) * 4); tot *= v_; if (p_ < tq) pre *= v_; } \
        float ka_[4], kb_[4]; \
        _Pragma("unroll") for (int i_ = 0; i_ < 4; ++i_) { const int t_ = 4 * tq + i_; const float eb0 = pre[0] * cs0[i_], eb1 = pre[1] * cs1[i_]; \
            const float kh0 = kk0[i_] * __builtin_amdgcn_rcpf(eb0), kh1 = kk1[i_] * __builtin_amdgcn_rcpf(eb1); \
            *(LAS unsigned*)(B_ + O_QH + t_ * 272 + pd) = pk2(bflo(rq[i_]) * eb0, bfhi(rq[i_]) * eb1); *(LAS unsigned*)(B_ + O_KH + t_ * 272 + pd) = pk2(kh0, kh1); ka_[i_] = kh0 * tot[0]; kb_[i_] = kh1 * tot[1]; } \
        *(LAS u32x2*)(B_ + O_KLT + (2 * dp) * 80 + tq * 8) = (u32x2){pk2(ka_[0], ka_[1]), pk2(ka_[2], ka_[3])}; *(LAS u32x2*)(B_ + O_KLT + (2 * dp + 1) * 80 + tq * 8) = (u32x2){pk2(kb_[0], kb_[1]), pk2(kb_[2], kb_[3])}; \
        *(LAS u32x2*)(B_ + O_VT + (2 * dp) * 80 + tq * 8) = (u32x2){(rv[0] & 0xffffu) | (rv[1] << 16), (rv[2] & 0xffffu) | (rv[3] << 16)}; \
        *(LAS u32x2*)(B_ + O_VT + (2 * dp + 1) * 80 + tq * 8) = (u32x2){(rv[0] >> 16) | (rv[1] & 0xffff0000u), (rv[2] >> 16) | (rv[3] & 0xffff0000u)}; \
        if (tq == 0) *(LAS f32x2*)(B_ + O_EBL + (2 * dp) * 4) = tot; } while (0)
        R3_LOAD(0, rq, rl, rv); gsr = __builtin_nontemporal_load((const GAS u32x4*)(gs_u + gi0)); R3_LOAD(1, nq, nl, nv);
        R3_WALK();
        __syncthreads();
        R3_PREP(0);
        R3_ROT(); R3_LOAD(2, nq, nl, nv);
        __syncthreads();
        for (int it = 0; it < SEQ / 32; ++it) {
            const LAS unsigned char* C_ = L + (it & 1) * SET;
            const bool more = it + 1 < SEQ / 32;
            if (more) R3_WALK();
            if (w < 3) {
                const int tt = (w + 1) >> 1, st = w >> 1;
                f32x4 a = ZERO4;
#pragma unroll
                for (int ks = 0; ks < 4; ++ks) { const bf16x8 qa = *(const LAS bf16x8*)(C_ + O_QH + (16 * tt + c16) * 272 + ks * 64 + g * 16), kb = *(const LAS bf16x8*)(C_ + O_KH + (16 * st + c16) * 272 + ks * 64 + g * 16);
                    a = MFMA16(qa, kb, a); }
#pragma unroll
                for (int r = 0; r < 4; ++r) { const int t = 16 * tt + 4 * g + r, s = 16 * st + c16; *(LAS bf16*)(L + O_ATT + t * 80 + s * 2) = f2bf(s <= t ? a[r] : 0.f); }
            } else if (w == 3) {
#pragma unroll
                for (int r = 0; r < 4; ++r) { const int t = 4 * g + r, s = 16 + c16; *(LAS bf16*)(L + O_ATT + t * 80 + s * 2) = (bf16)0; }
            }
            __syncthreads();
            if (more) { R3_PREP((it + 1) & 1); R3_ROT(); if (it + 3 < SEQ / 32) R3_LOAD(it + 3, nq, nl, nv); gsn = __builtin_nontemporal_load((const GAS u32x4*)(gs_u + ((unsigned)((it + 1) * 32 * HD) + gi0))); }
            {
                const bf16x8 bV = *(const LAS bf16x8*)(C_ + O_VT + (16 * w + c16) * 80 + g * 16);
                f32x4 o[2];
#pragma unroll
                for (int tt = 0; tt < 2; ++tt) { const bf16x8 aA = *(const LAS bf16x8*)(L + O_ATT + (16 * tt + c16) * 80 + g * 16); o[tt] = MFMA16(aA, bV, ZERO4); }
#pragma unroll
                for (int ks = 0; ks < 4; ++ks) {
                    const u32x4 sw = (u32x4){pk2(S[2 * ks][0], S[2 * ks][1]), pk2(S[2 * ks][2], S[2 * ks][3]), pk2(S[2 * ks + 1][0], S[2 * ks + 1][1]), pk2(S[2 * ks + 1][2], S[2 * ks + 1][3])};
                    const bf16x8 bS = __builtin_bit_cast(bf16x8, sw);
#pragma unroll
                    for (int tt = 0; tt < 2; ++tt) { const bf16x8 aQ = *(const LAS bf16x8*)(C_ + O_QH + (16 * tt + c16) * 272 + ks * 64 + g * 16); o[tt] = MFMA16(aQ, bS, o[tt]); } }
#pragma unroll
                for (int dt = 0; dt < 8; ++dt) { const f32x4 e4 = *(const LAS f32x4*)(C_ + O_EBL + (16 * dt + 4 * g) * 4); const bf16x8 aK = *(const LAS bf16x8*)(C_ + O_KLT + (16 * dt + c16) * 80 + g * 16);
                    S[dt] = MFMA16(aK, bV, S[dt] * e4); }
#pragma unroll
                for (int tt = 0; tt < 2; ++tt)
#pragma unroll
                    for (int r = 0; r < 4; ++r) ((LAS float*)(L + O_OB))[(16 * tt + 4 * g + r) * 132 + 16 * w + c16] = o[tt][r];
            }
            __syncthreads();
            {
                const LAS unsigned char* op = L + O_OB + (((4 * w + (lane >> 4)) * 132) + (lane & 15) * 8) * 4;
                const f32x4 a = *(const LAS f32x4*)op, b_ = *(const LAS f32x4*)(op + 16);
                float ss = (a[0] * a[0] + a[1] * a[1]) + (a[2] * a[2] + a[3] * a[3]) + (b_[0] * b_[0] + b_[1] * b_[1]) + (b_[2] * b_[2] + b_[3] * b_[3]);
                ss += dppf<0xB1>(ss); ss += dppf<0x4E>(ss); ss += dppf<0x141>(ss); ss += dppf<0x140>(ss);
                const float rstd = 1.0f / sqrtf(ss * (1.0f / HD) + NORM_EPS);
                const u32x4 gs = gsr; const f32x4 an = a * rstd * gn0, bn = b_ * rstd * gn1;
                u32x4 w_; w_.x = pk2(an[0] * bflo(gs.x), an[1] * bfhi(gs.x)); w_.y = pk2(an[2] * bflo(gs.y), an[3] * bfhi(gs.y)); w_.z = pk2(bn[0] * bflo(gs.z), bn[1] * bfhi(gs.z)); w_.w = pk2(bn[2] * bflo(gs.w), bn[3] * bfhi(gs.w));
                *(GAS u32x4*)(o0_u + ((unsigned)(it * 32 * DM) + go0)) = w_;
                gsr = gsn;
            }
        }
#undef R3_LOAD
#undef R3_ROT
#undef R3_WALK
#undef R3_PREP
        __syncthreads();
    }
}

namespace at2 {
typedef float f32x16 __attribute__((ext_vector_type(16)));
#define AT_KSWZ(row, colB) ((row) * 256 + ((colB) ^ (((row) & 7) << 4)))
#define AT_SBAR() __builtin_amdgcn_sched_barrier(0)
constexpr int SHM_V = 16384, SHM_K = 16384;
constexpr float THRL = 11.5f;
#ifndef AT_SDEPTH
#define AT_SDEPTH 2
#endif
__device__ __forceinline__ int crow(int r, int hi) { return (r & 3) + 8 * (r >> 2) + 4 * hi; }
__device__ __forceinline__ u32x2 split3(float x) {
    const unsigned w0 = pk2(x, 0.f) & 0xffffu; const float r1 = x - __uint_as_float(w0 << 16);
    const unsigned w1 = pk2(r1, 0.f) & 0xffffu; const float r2 = r1 - __uint_as_float(w1 << 16);
    const unsigned w2 = pk2(r2, 0.f) & 0xffffu;
    return (u32x2){w0 | (w1 << 16), w2};
}
template <bool FIRST> __device__ __forceinline__ void partialSM(f32x16& p0, f32x16& p1, float& m_reg, float& alpha, u32x2& qm, bool diag, int thr_in, int hi) {
    const float NEG = -__builtin_inff();
    if (diag) { int thr = thr_in; asm volatile("" : "+v"(thr));
#pragma unroll
        for (int r = 0; r < 16; ++r) { const int c = (r & 3) + 8 * (r >> 2); if (c > thr) p0[r] = NEG; if (c + 32 > thr) p1[r] = NEG; }
    }
    float pmax = p0[0];
#pragma unroll
    for (int r = 1; r < 16; ++r) pmax = fmaxf(pmax, p0[r]);
#pragma unroll
    for (int r = 0; r < 16; ++r) pmax = fmaxf(pmax, p1[r]);
    { auto rr = __builtin_amdgcn_permlane32_swap(__float_as_uint(pmax), __float_as_uint(pmax), false, false);
      pmax = fmaxf(__uint_as_float(rr[0]), __uint_as_float(rr[1])); }
    if (!FIRST && __builtin_expect(__all(pmax <= THRL), 1)) { alpha = 1.f; }
    else { const float d = FIRST ? pmax : fmaxf(pmax, 0.f);
        alpha = FIRST ? 1.f : __builtin_amdgcn_exp2f(-d); m_reg = FIRST ? d : m_reg + d;
#pragma unroll
        for (int r = 0; r < 16; ++r) { p0[r] -= d; p1[r] -= d; }
        const u32x2 s3 = split3(-m_reg); qm.x = hi ? 0u : s3.x; qm.y = hi ? 0u : s3.y; }
#pragma unroll
    for (int r = 0; r < 16; ++r) p0[r] = __builtin_amdgcn_exp2f(p0[r]);
    asm volatile("" : "+v"(p0), "+v"(p1));
}
__device__ __forceinline__ void finishSM(f32x16& p0, f32x16& p1, float alpha, float& l_reg, bf16x8& pa0, bf16x8& pa1, bf16x8& pa2, bf16x8& pa3) {
#pragma unroll
    for (int r = 0; r < 16; ++r) p1[r] = __builtin_amdgcn_exp2f(p1[r]);
    float ps = 0.f;
#pragma unroll
    for (int r = 0; r < 16; ++r) ps += p0[r];
#pragma unroll
    for (int r = 0; r < 16; ++r) ps += p1[r];
    { auto rr = __builtin_amdgcn_permlane32_swap(__float_as_uint(ps), __float_as_uint(ps), false, false);
      ps = __uint_as_float(rr[0]) + __uint_as_float(rr[1]); }
    l_reg = l_reg * alpha + ps;
#define AT_PK4(P, BASE, OUT) do { const u32x4 w_ = {pk2(P[BASE + 0], P[BASE + 1]), pk2(P[BASE + 2], P[BASE + 3]), pk2(P[BASE + 4], P[BASE + 5]), pk2(P[BASE + 6], P[BASE + 7])}; \
    OUT = __builtin_bit_cast(bf16x8, w_); } while (0)
    AT_PK4(p0, 0, pa0); AT_PK4(p0, 8, pa1); AT_PK4(p1, 0, pa2); AT_PK4(p1, 8, pa3);
#undef AT_PK4
}
template <int OFF> __device__ __forceinline__ bf16x8 k_read(int a) {
    bf16x8 r; asm volatile("ds_read_b128 %0, %1 offset:%2" : "=&v"(r) : "v"(a), "i"(OFF) : "memory"); return r;
}
__device__ __forceinline__ void qkt(f32x16& p0, f32x16& p1, const LAS unsigned char* Ks, const int (&kb)[4], const bf16x8* qr, u32x2 qme) {
    const int k0 = (int)(unsigned)(uintptr_t)Ks;
    const int a0 = k0 + kb[0], a1 = k0 + kb[1], a2 = k0 + kb[2], a3 = k0 + kb[3];
#define AT_KRD(F, a) do { F[0] = k_read<0>(a); F[1] = k_read<8192>(a); F[2] = k_read<128>(a); F[3] = k_read<8320>(a); } while (0)
#define AT_KMM(F, i) do { p0 = __builtin_amdgcn_mfma_f32_32x32x16_bf16(F[0], qr[i], p0, 0, 0, 0); p1 = __builtin_amdgcn_mfma_f32_32x32x16_bf16(F[1], qr[i], p1, 0, 0, 0); \
        p0 = __builtin_amdgcn_mfma_f32_32x32x16_bf16(F[2], qr[(i) + 4], p0, 0, 0, 0); p1 = __builtin_amdgcn_mfma_f32_32x32x16_bf16(F[3], qr[(i) + 4], p1, 0, 0, 0); } while (0)
    bf16x8 fa[4], fb[4];
    AT_KRD(fa, a0); AT_KRD(fb, a1);
    f32x16 z;
#pragma unroll
    for (int r = 0; r < 16; ++r) z[r] = 0.f;
    const s16x4 ones = __builtin_bit_cast(s16x4, (u32x2){0x3F803F80u, 0x3F803F80u}), qb = __builtin_bit_cast(s16x4, qme);
    p0 = __builtin_amdgcn_mfma_f32_32x32x8bf16_1k(ones, qb, z, 0, 0, 0);
    p1 = p0; AT_SBAR();
    asm volatile("s_waitcnt lgkmcnt(4)" ::: "memory"); AT_SBAR(); AT_KMM(fa, 0); AT_SBAR(); AT_KRD(fa, a2);
    asm volatile("s_waitcnt lgkmcnt(4)" ::: "memory"); AT_SBAR(); AT_KMM(fb, 1); AT_SBAR(); AT_KRD(fb, a3);
    asm volatile("s_waitcnt lgkmcnt(4)" ::: "memory"); AT_SBAR(); AT_KMM(fa, 2); AT_SBAR();
    asm volatile("s_waitcnt lgkmcnt(0)" ::: "memory"); AT_SBAR(); AT_KMM(fb, 3);
#undef AT_KRD
#undef AT_KMM
}
__device__ __forceinline__ int v_st(int k, int c) { return ((k >> 3) * 4 + (c >> 5)) * 512 + ((k & 7) * 32 + (c & 31)) * 2; }
__device__ __forceinline__ int v_rd_base(int lane) { return ((lane & 3) << 3) | (((lane >> 2) & 3) << 6) | (((lane >> 4) & 1) << 5) | (((lane >> 5) & 1) << 8); }
constexpr int v_rd_off(int d0, int ks, int half) { return d0 * 512 + ks * 4096 + half * 2048; }
template <int OFF> __device__ __forceinline__ s16x4 tr_read(int vb) {
    s16x4 r; asm volatile("ds_read_b64_tr_b16 %0, %1 offset:%2" : "=&v"(r) : "v"(vb), "i"(OFF) : "memory"); return r;
}
template <int D0> __device__ __forceinline__ void pv_one(f32x16& od, int vb, bf16x8 pa0, bf16x8 pa1, bf16x8 pa2, bf16x8 pa3) {
    const s16x4 l0 = tr_read<v_rd_off(D0, 0, 0)>(vb), h0 = tr_read<v_rd_off(D0, 0, 1)>(vb), l1 = tr_read<v_rd_off(D0, 1, 0)>(vb), h1 = tr_read<v_rd_off(D0, 1, 1)>(vb);
    const s16x4 l2 = tr_read<v_rd_off(D0, 2, 0)>(vb), h2 = tr_read<v_rd_off(D0, 2, 1)>(vb), l3 = tr_read<v_rd_off(D0, 3, 0)>(vb), h3 = tr_read<v_rd_off(D0, 3, 1)>(vb);
    asm volatile("s_waitcnt lgkmcnt(0)" ::: "memory"); AT_SBAR();
#define AT_PK(Lo, Hi) (bf16x8){Lo[0], Lo[1], Lo[2], Lo[3], Hi[0], Hi[1], Hi[2], Hi[3]}
    od = __builtin_amdgcn_mfma_f32_32x32x16_bf16(pa0, AT_PK(l0, h0), od, 0, 0, 0);
    od = __builtin_amdgcn_mfma_f32_32x32x16_bf16(pa1, AT_PK(l1, h1), od, 0, 0, 0);
    od = __builtin_amdgcn_mfma_f32_32x32x16_bf16(pa2, AT_PK(l2, h2), od, 0, 0, 0);
    od = __builtin_amdgcn_mfma_f32_32x32x16_bf16(pa3, AT_PK(l3, h3), od, 0, 0, 0);
#undef AT_PK
}
__device__ __forceinline__ void pv_d0(f32x16* o, int vb, bf16x8 pa0, bf16x8 pa1, bf16x8 pa2, bf16x8 pa3) {
    pv_one<0>(o[0], vb, pa0, pa1, pa2, pa3); pv_one<1>(o[1], vb, pa0, pa1, pa2, pa3); pv_one<2>(o[2], vb, pa0, pa1, pa2, pa3); pv_one<3>(o[3], vb, pa0, pa1, pa2, pa3);
}
}

template <bool LEAD> __device__ __forceinline__ void p7_body(Frame& F) {
    using namespace at2;
    LAS unsigned char* L = F.lds;
    constexpr int O_K = 0, O_V = 4 * SHM_K, O_WS = 4 * SHM_K + 4 * SHM_V, O_KM = O_WS + 2048, O_OST = O_K + 2 * SHM_K;
    const int tid = F.tid, lane = F.lane, wid = F.wave, r32 = lane & 31, hi = lane >> 5;
    const bf16* QB = F.S4; const bf16* KB = F.S2; const bf16* VB = F.S3; const bf16* ZS = F.S5; bf16* A1 = F.S6;
    const float NEG_INF = -__builtin_inff();
    LAS float* li_l = (LAS float*)(L + O_WS) + wid * 64; LAS float* al_l = li_l + 32;
    const int vb0 = (int)(unsigned)(uintptr_t)(L + O_V) + v_rd_base(lane);
    int kb[4];
    { int r_ = lane; asm volatile("" : "+v"(r_)); const int rr_ = r_ & 31, base_ = rr_ * 256 + ((((r_ >> 5) ^ rr_) & 1) << 4), x_ = (rr_ >> 1) & 3;
#pragma unroll
      for (int i = 0; i < 4; ++i) kb[i] = base_ + ((i ^ x_) << 5); }
    unsigned kvo0, kvo1, vvo;
    { int ln_ = lane; asm volatile("" : "+v"(ln_));
      const int rq = ln_ >> 4, cx = ln_ & 15;
      kvo0 = (unsigned)((8 * wid + rq) * 256 + ((cx ^ rq) << 4));
      kvo1 = (unsigned)((8 * wid + 4 + rq) * 256 + ((cx ^ (4 + rq)) << 4));
      const int key = 8 * wid + ((ln_ >> 2) & 7);
      vvo = (unsigned)(key * 256 + (ln_ >> 5) * 64 + (ln_ & 3) * 16); }
    const int ngrp = F.G / 4, mem = F.vcu & 3, bh0 = F.vcu >> 2;
    const int nun = (ngrp > 0 && bh0 < BATCH * NH) ? 2 * ((BATCH * NH - bh0 + ngrp - 1) / ngrp) : 0;
    bf16x8 qr[8];
    float kmr[2];
#define AT_UBH(u) (bh0 + ((u) >> 1) * ngrp)
#define AT_UJ(u) (((u) & 1) ? 7 - mem : mem)
#define AT_KROW(bhv, jv, t) ((size_t)(bhv) * pg8::HM_ROWS + (size_t)(((t) < 4) ? (jv) : (((t) - 4) >> 2)) * 256 + (size_t)((t) & 3) * 64)
#define AT_DMA(sb, bhv, jv, t) do { const size_t k0_ = AT_KROW(bhv, jv, t) * HD; const char* vt_ = (const char*)(VB + k0_); const char* kt_ = (const char*)(KB + k0_); \
    __builtin_amdgcn_global_load_lds((const unsigned*)(kt_ + kvo0), (LAS unsigned*)(L + O_K + (sb) + wid * 2048), 16, 0, 0); \
    __builtin_amdgcn_global_load_lds((const unsigned*)(kt_ + kvo1), (LAS unsigned*)(L + O_K + (sb) + wid * 2048 + 1024), 16, 0, 0); \
    __builtin_amdgcn_global_load_lds((const unsigned*)(vt_ + vvo), (LAS unsigned*)(L + O_V + (sb) + wid * 2048), 16, 0, 0); \
    __builtin_amdgcn_global_load_lds((const unsigned*)(vt_ + 128 + vvo), (LAS unsigned*)(L + O_V + (sb) + wid * 2048 + 1024), 16, 0, 0); } while (0)
#define AT_BAR(N) do { AT_SBAR(); asm volatile("s_waitcnt vmcnt(" #N ")" ::: "memory"); __builtin_amdgcn_s_barrier(); AT_SBAR(); } while (0)
#define AT_RESC(a) do { if (__any((a) < 1.f)) { if (hi == 0) al_l[r32] = (a); asm volatile("s_waitcnt lgkmcnt(0)" ::: "memory"); \
    _Pragma("unroll") for (int d_ = 0; d_ < 4; ++d_) _Pragma("unroll") for (int r_ = 0; r_ < 16; ++r_) o[d_][r_] *= al_l[crow(r_, hi)]; } } while (0)
#define AT_PSM(P0, P1, AL, t) partialSM<false>(P0, P1, m_reg, AL, qm, (t) < 4 && ((t) & 3) == (wid >> 1), qrel - (64 * ((t) & 3) + 4 * hi), hi)
#define AT_QME(t) ({ const bool rs_ = ((t) < 4) ? (((t) & 3) <= (wid >> 1)) : (((mk >> (((t) - 4) >> 2)) & 1u) != 0u); (u32x2){rs_ ? qm.x : negpk, rs_ ? qm.y : 0u}; })
#define AT_UNIT_REQ(u) do { const int bhn_ = AT_UBH(u), jn_ = AT_UJ(u); const bf16* qn_ = QB + ((size_t)(bhn_ >> 3) * SEQ + (size_t)jn_ * 256) * DM + (bhn_ & 7) * HD; \
    int ln_ = lane; asm volatile("" : "+v"(ln_)); const unsigned qo_ = (unsigned)((32 * wid + (ln_ & 31)) * DM + (ln_ >> 5) * 8); \
    _Pragma("unroll") for (int d0 = 0; d0 < 8; ++d0) qr[d0] = *(const GAS bf16x8*)(qn_ + (qo_ + d0 * 16)); \
    AT_DMA(0, bhn_, jn_, 0); AT_DMA(SHM_K, bhn_, jn_, 1); \
    if (((u) & 1) == 0) { _Pragma("unroll") for (int i_ = 0; i_ < 2; ++i_) { const int e_ = tid + 512 * i_; const float* kp_ = F.KM + ((size_t)(bhn_ * 8 + (e_ >> 7)) * 2) * 128 + (e_ & 127); kmr[i_] = kp_[0] + kp_[128]; } } } while (0)
    if (nun > 0) AT_UNIT_REQ(0);
    for (int u = 0; u < nun; ++u) {
        const int bh = AT_UBH(u), j = AT_UJ(u), b = bh >> 3, h = bh & 7, hcol = h * HD;
        const size_t qrow0 = (size_t)b * SEQ + (size_t)j * 256;
        if ((u & 1) == 0) {
            __syncthreads();
            ((LAS float*)(L + O_KM))[tid] = kmr[0]; ((LAS float*)(L + O_KM))[tid + 512] = kmr[1];
            __syncthreads();
        }
        const int qrel = 32 * wid + r32;
        const int NT = 4 * (j + 1);
        float m_reg = 0.f, l_reg = 0.f; f32x16 o[4];
#pragma unroll
        for (int d = 0; d < 4; ++d)
#pragma unroll
            for (int r = 0; r < 16; ++r) o[d][r] = 0.f;
        f32x16 pA0, pA1, pB0, pB1; float alA, alB; bf16x8 pa0, pa1, pa2, pa3; u32x2 qm = (u32x2){0u, 0u}; const unsigned negpk = hi ? 0u : 0x0000FF80u;
        unsigned mk = 0u;
        {
            float gt[7];
#pragma unroll
            for (int nb = 0; nb < 7; ++nb) { float s_ = NEG_INF;
                if (nb < j) { s_ = 0.f; const LAS f32x4* kp = (const LAS f32x4*)(L + O_KM + (nb * 128 + hi * 8) * 4);
#pragma unroll
                    for (int d0 = 0; d0 < 8; ++d0) { const u32x4 q = __builtin_bit_cast(u32x4, qr[d0]); const f32x4 k0 = kp[4 * d0], k1 = kp[4 * d0 + 1];
                        s_ += (bflo(q.x) * k0[0] + bfhi(q.x) * k0[1]) + (bflo(q.y) * k0[2] + bfhi(q.y) * k0[3]) + (bflo(q.z) * k1[0] + bfhi(q.z) * k1[1]) + (bflo(q.w) * k1[2] + bfhi(q.w) * k1[3]); }
                    s_ += __shfl_xor(s_, 32); }
                gt[nb] = s_; }
#pragma unroll
            for (int nb = 0; nb < 7; ++nb) { int cnt = 0;
#pragma unroll
                for (int mb = 0; mb < 7; ++mb) if (mb != nb) cnt += ((gt[mb] > gt[nb]) || (gt[mb] == gt[nb] && mb < nb)) ? 1 : 0;
                if (nb < j && cnt < 3) mk |= 1u << nb; }
        }
        AT_SBAR(); __builtin_amdgcn_s_barrier(); AT_SBAR();
        AT_DMA(2 * SHM_K, bh, j, 2);
        AT_BAR(4);
        qkt(pA0, pA1, L + O_K, kb, qr, qm); partialSM<true>(pA0, pA1, m_reg, alA, qm, (wid >> 1) == 0, qrel - 4 * hi, hi);
#define AT_STEP(PN0, PN1, KS, ALN, PO0, PO1, ALO, VS, TN, LOADSTMT) do { \
        if constexpr (LEAD) { AT_SBAR(); qkt(PN0, PN1, L + O_K + (KS), kb, qr, AT_QME(TN)); AT_SBAR(); finishSM(PO0, PO1, ALO, l_reg, pa0, pa1, pa2, pa3); AT_SBAR(); LOADSTMT; AT_SBAR(); \
                    pv_d0(o, vb0 + (VS), pa0, pa1, pa2, pa3); AT_SBAR(); AT_PSM(PN0, PN1, ALN, TN); AT_SBAR(); } \
        else                { AT_SBAR(); finishSM(PO0, PO1, ALO, l_reg, pa0, pa1, pa2, pa3); AT_SBAR(); qkt(PN0, PN1, L + O_K + (KS), kb, qr, AT_QME(TN)); AT_SBAR(); LOADSTMT; AT_SBAR(); \
                    AT_PSM(PN0, PN1, ALN, TN); AT_SBAR(); pv_d0(o, vb0 + (VS), pa0, pa1, pa2, pa3); AT_SBAR(); } } while (0)
        int kofs = 0;
        for (int n = 1; n + 1 < NT; n += 2) {
            AT_STEP(pB0, pB1, SHM_K + kofs, alB, pA0, pA1, alA, kofs, n, AT_DMA(3 * SHM_K - kofs, bh, j, n + 2));
            AT_RESC(alB); AT_BAR(4);
            const bool more = n + 3 < NT;
            AT_STEP(pA0, pA1, 2 * SHM_K - kofs, alA, pB0, pB1, alB, SHM_V + kofs, n + 1, if (more) AT_DMA(kofs, bh, j, n + 3));
            AT_RESC(alA); if (more) AT_BAR(4); else AT_BAR(0);
            kofs ^= 2 * SHM_K;
        }
        AT_STEP(pB0, pB1, 3 * SHM_K, alB, pA0, pA1, alA, 2 * SHM_V, NT - 1, if (u + 1 < nun) AT_UNIT_REQ(u + 1));
        AT_SBAR(); __builtin_amdgcn_s_barrier(); AT_SBAR();
        AT_RESC(alB);
        finishSM(pB0, pB1, alB, l_reg, pa0, pa1, pa2, pa3); AT_SBAR();
        pv_d0(o, vb0 + 3 * SHM_V, pa0, pa1, pa2, pa3);
#undef AT_STEP
        if (hi == 0) li_l[r32] = l_reg; asm volatile("s_waitcnt lgkmcnt(0)" ::: "memory");
        {
            LAS unsigned char* st = L + O_OST + wid * 4096;
            int ln2_ = lane; asm volatile("" : "+v"(ln2_));
            const bf16* zs_u = ZS + qrow0 * DM + hcol; bf16* a1_u = A1 + qrow0 * DM + hcol;
            const unsigned ro0 = (unsigned)((32 * wid + (ln2_ >> 4)) * DM + (ln2_ & 15) * 8); const int so_ = (ln2_ >> 4) * 256 + (ln2_ & 15) * 16;
            u32x4 zz[8];
#pragma unroll
            for (int i = 0; i < 8; ++i) zz[i] = *(const GAS u32x4*)(zs_u + (ro0 + i * 4 * DM));
            LAS unsigned char* stw = st + (ln2_ >> 5) * 1024 + (ln2_ & 31) * 2;
            const LAS float* lil = li_l + 4 * (ln2_ >> 5);
#pragma unroll
            for (int ps = 0; ps < 2; ++ps) {
#pragma unroll
                for (int r8 = 0; r8 < 8; ++r8) { const int r = 8 * ps + r8, ro_ = (r8 & 3) + 8 * (r8 >> 2); const float rl = __builtin_amdgcn_rcpf(lil[(r & 3) + 8 * (r >> 2)]);
#pragma unroll
                    for (int d0 = 0; d0 < 4; ++d0) *(LAS bf16*)(stw + ro_ * 256 + d0 * 64) = f2bf(o[d0][r] * rl); }
#pragma unroll
                for (int ii = 0; ii < 4; ++ii) { const int i = 4 * ps + ii; const u32x4 z = zz[i]; const u32x4 ov = *(const LAS u32x4*)(st + so_ + ii * 1024);
                    u32x4 w_; w_.x = pk2(bflo(ov.x) * bflo(z.x), bfhi(ov.x) * bfhi(z.x)); w_.y = pk2(bflo(ov.y) * bflo(z.y), bfhi(ov.y) * bfhi(z.y));
                    w_.z = pk2(bflo(ov.z) * bflo(z.z), bfhi(ov.z) * bfhi(z.z)); w_.w = pk2(bflo(ov.w) * bflo(z.w), bfhi(ov.w) * bfhi(z.w));
                    *(GAS u32x4*)(a1_u + (ro0 + i * 4 * DM)) = w_; }
            }
        }
    }
    asm volatile("s_waitcnt vmcnt(0)" ::: "memory");
    __syncthreads();
#undef AT_UBH
#undef AT_UJ
#undef AT_KROW
#undef AT_DMA
#undef AT_BAR
#undef AT_RESC
#undef AT_PSM
#undef AT_QME
#undef AT_UNIT_REQ
}
__device__ __forceinline__ void p7_attention2(Frame& F) { if (F.wave < 4) p7_body<true>(F); else p7_body<false>(F); }

struct Args { const void* in[15]; float* out; unsigned char* ws; int ph_lo, ph_hi; };
__global__ void __launch_bounds__(NWAVES * 64, 2) fwd(Args args) {
    extern __shared__ __attribute__((aligned(16))) unsigned char lds[];
    Frame F;
    F.lds = (LAS unsigned char*)lds;
    F.tid = threadIdx.x; F.lane = F.tid & 63; F.wave = __builtin_amdgcn_readfirstlane(F.tid >> 6);
    F.G = gridDim.x; { const int bx = blockIdx.x; F.vcu = (F.G % 8 == 0) ? (bx % 8) * (F.G / 8) + bx / 8 : bx; }
    unsigned char* ws = args.ws;
    F.x = (const float*)args.in[0]; F.c = (const float*)args.in[1]; F.pos = (const int*)args.in[2]; F.mod_w = (const float*)args.in[3]; F.mod_b = (const float*)args.in[4];
    F.pre_g = (const float*)args.in[5]; F.post_g = (const float*)args.in[6]; F.a_w_in = (const float*)args.in[7]; F.a_w_out = (const float*)args.in[8]; F.a_gn = (const float*)args.in[9];
    F.a_lb = (const float*)args.in[10]; F.kv_g = (const float*)args.in[11]; F.w_kv = (const float*)args.in[12]; F.b_w_in = (const float*)args.in[13]; F.b_w_out = (const float*)args.in[14];
    F.out = args.out;
    F.Win0 = (bf16*)(ws + WS_WIN0); F.Wout0 = (bf16*)(ws + WS_WOUT0); F.Wkv = (bf16*)(ws + WS_WKV); F.Win1 = (bf16*)(ws + WS_WIN1); F.Wout1 = (bf16*)(ws + WS_WOUT1);
    F.MOD = (float*)(ws + WS_MOD); F.LB = (float*)(ws + WS_LB); F.TAB = (float*)(ws + WS_TAB); F.KM = (float*)(ws + WS_KM);
    F.S0 = (bf16*)(ws + WS_S0); F.S1 = (bf16*)(ws + WS_S1); F.S2 = (bf16*)(ws + WS_S2); F.S3 = (bf16*)(ws + WS_S3); F.S4 = (bf16*)(ws + WS_S4); F.S5 = (bf16*)(ws + WS_S5); F.S6 = (bf16*)(ws + WS_S6);
    volatile LAS unsigned* MISC = (volatile LAS unsigned*)(F.lds + MISC_OFF);
    for (int u = F.tid; u < (LDS_BYTES - LDSCTL_OFF) / 4; u += NWAVES * 64) ((LAS unsigned*)(F.lds + LDSCTL_OFF))[u] = 0u;
    __syncthreads();
    XcdBarrier bar; bar.bar = (unsigned*)(ws + WS_CTL) + CW_BAR; bar.x = 0; bar.st = nullptr;
    if (N_LAUNCHES == 1) bar = xcd_barrier_post((unsigned*)(ws + WS_CTL) + CW_BAR, MISC + 8);
    const int lo = args.ph_lo, hi = args.ph_hi;
#define IN(k) (lo <= (k) && (k) < hi)
#define SEAM(k) do { if (IN(k) && IN((k) + 1)) xcd_barrier(bar); } while (0)
#define WGSEAM(k) do { if (IN(k) && IN((k) + 1)) { asm volatile("s_waitcnt vmcnt(0)" ::: "memory"); __syncthreads(); } } while (0)

    if (IN(0)) { p0_prologue(F); } SEAM(0);
    if (IN(1)) { p1_modnorm(F); } SEAM(1);
    if (IN(2)) {
        pg8::Gemm g{F.S0, F.Win0, M, 4096, DM}; pg8::StaticOrder S; S.init(M, 4096, F.G, (int)blockIdx.x);
        pg8::EpiL0 E{F.S1, F.S2, F.S3, F.S4, F.LB};
        pg8::gemm_phase<pg8::EpiL0, pg8::StaticOrder, true, true>(F.lds, g, S, E);
    } SEAM(2);
    if (IN(3)) { p3_recurrence3(F); } SEAM(3);
    if (IN(4)) {
        pg8::Gemm g{F.S5, F.Wout0, M, DM, DM}; pg8::PanelOrder S; S.init(M, DM, F.G, F.vcu);
        pg8::EpiBf16<0> E{F.S6, DM, nullptr, 0, 0, 1.f};
        pg8::gemm_phase<pg8::EpiBf16<0>, pg8::PanelOrder, true, true>(F.lds, g, S, E);
    } WGSEAM(4);
    if (IN(5)) { p5_mid(F); } SEAM(5);
    if (IN(6)) {
        { pg8::Gemm g{F.S1, F.Wkv, M, 2048, DM}; pg8::StaticOrder S; S.init(M, 2048, F.G, (int)blockIdx.x);
          pg8::EpiKV E{F.S2, F.S3, F.pos, F.TAB, F.KM};
          pg8::gemm_phase<pg8::EpiKV, pg8::StaticOrder, true, true>(F.lds, g, S, E); }
        { pg8::Gemm g{F.S0, F.Win1, M, 2048, DM}; pg8::StaticOrder S; S.init(M, 2048, F.G, (int)blockIdx.x);
          pg8::EpiQZ E{F.S4, F.S5, F.pos, F.TAB, QSCALE};
          pg8::gemm_phase<pg8::EpiQZ, pg8::StaticOrder, true, true>(F.lds, g, S, E); }
    } SEAM(6);
    if (IN(7)) { p7_attention2(F); } SEAM(7);
    if (IN(8)) {
        pg8::Gemm g{F.S6, F.Wout1, M, DM, DM}; pg8::PanelOrder S; S.init(M, DM, F.G, F.vcu);
        pg8::EpiBf16<0> E{F.S0, DM, nullptr, 0, 0, 1.f};
        pg8::gemm_phase<pg8::EpiBf16<0>, pg8::PanelOrder, true, true>(F.lds, g, S, E);
    } WGSEAM(8);
    if (IN(9)) { p9_final(F); }
#undef IN
#undef SEAM
#undef WGSEAM
}

extern "C" void kernel_launch(void* const* d_in, const int* in_sizes, int n_in, void* d_out, int out_size, void* d_ws, size_t ws_size, hipStream_t stream) {
    static int grid = 0;
    if (grid == 0) {
        if (n_in != 15 || in_sizes[0] != M * DM || out_size != M * DM || ws_size < WS_END) { fprintf(stderr, "kernel_launch: unexpected shapes (n_in %d, in0 %d, out %d, ws %zu); nothing launched\n", n_in, n_in > 0 ? in_sizes[0] : -1, out_size, ws_size); grid = -1; return; }
        int dev = 0, cus = 0, per_cu = 0;
        if (hipGetDevice(&dev) != hipSuccess || hipDeviceGetAttribute(&cus, hipDeviceAttributeMultiprocessorCount, dev) != hipSuccess) { grid = -1; return; }
        if (hipFuncSetAttribute((const void*)fwd, hipFuncAttributeMaxDynamicSharedMemorySize, LDS_BYTES) != hipSuccess) { fprintf(stderr, "kernel_launch: hipFuncSetAttribute failed\n"); grid = -1; return; }
        if (hipOccupancyMaxActiveBlocksPerMultiprocessor(&per_cu, (const void*)fwd, NWAVES * 64, LDS_BYTES) != hipSuccess || per_cu < 1) { fprintf(stderr, "kernel_launch: occupancy query says %d blocks per CU\n", per_cu); }
        (void)hipGetLastError();
        grid = cus;
    }
    if (grid < 0) return;
    static_assert((size_t)(CW_BAR + XCD_BAR_WORDS) * 4 <= CTL_ZERO_BYTES, "the zeroed control region must cover the barrier words");
    if (hipMemsetAsync((char*)d_ws + WS_CTL, 0, CTL_ZERO_BYTES, stream) != hipSuccess) { fprintf(stderr, "kernel_launch: memset failed\n"); return; }
    Args a{};
    for (int i = 0; i < 15; ++i) a.in[i] = d_in[i];
    a.out = (float*)d_out; a.ws = (unsigned char*)d_ws;
    for (int li = 0; li < N_LAUNCHES; ++li) {
        a.ph_lo = (N_LAUNCHES == 1) ? 0 : li; a.ph_hi = (N_LAUNCHES == 1) ? NPH : li + 1;
        hipLaunchKernelGGL(fwd, dim3(grid), dim3(NWAVES * 64), LDS_BYTES, stream, a);
        const hipError_t le = hipPeekAtLastError();
        if (le != hipSuccess) { fprintf(stderr, "kernel_launch: launch %d failed: %s\n", li, hipGetErrorName(le)); break; }
    }
}
```

```cpp
#include <hip/hip_runtime.h>
#include <cstdio>
#include <cstdint>
namespace pg8 {
#define PG8_LAS __attribute__((address_space(3)))
typedef unsigned short bf16_t;
typedef short bf16x8 __attribute__((ext_vector_type(8)));
typedef float f32x4 __attribute__((ext_vector_type(4)));
typedef unsigned u32x4 __attribute__((ext_vector_type(4)));
constexpr int BM = 256, BK = 64, HALF = 128, HTB = HALF * BK * 2  , STAGE_BYTES = 8 * HTB, NXCD = 8, WGM = 8;

__host__ __device__ __forceinline__ int lds_byte(int r, int c) { const int st = (r >> 4) * 2 + (c >> 5), rr = r & 15, cc = c & 31, ob = rr * 64 + cc * 2; return st * 1024 + (ob ^ (((ob >> 9) & 1) << 5)); }
__host__ __device__ __forceinline__ void stage_rc(int b, int& R, int& C) { const int st = b / 1024, sb = b % 1024, swz = sb ^ (((sb >> 9) & 1) << 5); R = (st >> 1) * 16 + swz / 64; C = (st & 1) * 32 + (swz % 64) / 2; }
__host__ __device__ __forceinline__ int perm32(int rho) { const int n = rho >> 4, i = rho & 15; return 8 * (i >> 2) + 4 * n + (i & 3); }

struct Unit { int pm, pn; };
struct Gemm { const bf16_t* A; const bf16_t* Bt; int M, N, K; };

struct StaticOrder {
    int nM, nN, nwg, G, c;
    __host__ __device__ void init(int M, int N, int G_, int c_) { nM = M / BM; nN = N / BM; nwg = nM * nN; G = G_; c = c_; }
    __host__ __device__ bool next(int i, Unit& u) const {
        const long L = (long)i * G + c; if (L >= nwg) return false;
        int wgid = (int)L; { const int q = nwg / NXCD, r = nwg % NXCD, xcd = wgid % NXCD, off = wgid / NXCD; wgid = (xcd < r ? xcd * (q + 1) : r * (q + 1) + (xcd - r) * q) + off; }
        const int nig = WGM * nN, gid = wgid / nig, fm = gid * WGM, gsz = (nM - fm) < WGM ? (nM - fm) : WGM;
        u.pm = fm + ((wgid % nig) % gsz); u.pn = (wgid % nig) / gsz; return true;
    }
    __device__ __forceinline__ void a_ready(const Unit&) const {}
    __device__ __forceinline__ void done(const Unit&) const {}
};

typedef float cvt_f32x2_t __attribute__((ext_vector_type(2))); typedef __bf16 cvt_bf16x2_t __attribute__((ext_vector_type(2)));
__device__ __forceinline__ unsigned cvt_pk_bf16(float lo, float hi) { const cvt_f32x2_t v = {lo, hi}; const cvt_bf16x2_t b = __builtin_convertvector(v, cvt_bf16x2_t); return __builtin_bit_cast(unsigned, b); }
typedef float f32x2 __attribute__((ext_vector_type(2)));
__device__ __forceinline__ f32x2 gelu_pk(f32x2 v) {
    const f32x2 av = __builtin_elementwise_abs(v), d = av * 0.2316418882f + 1.0f;
    f32x2 t; t.x = __builtin_amdgcn_rcpf(d.x); t.y = __builtin_amdgcn_rcpf(d.y);
    f32x2 q = t * 0.5307027145f + (-0.7265760135f); q = q * t + 0.7107068705f; q = q * t + (-0.142248368f); q = q * t + 0.127414796f; q = q * t;
    const f32x2 s = (v * v) * (-0.72134752044f);
    f32x2 e; e.x = __builtin_amdgcn_exp2f(s.x); e.y = __builtin_amdgcn_exp2f(s.y);
    const f32x2 m = v * (q * e), r = v - m;
    f32x2 o; o.x = v.x < 0.f ? m.x : r.x; o.y = v.y < 0.f ? m.y : r.y; return o;
}

template <int ACT  > struct EpiBf16 {
    static constexpr bool PERM = true, AFTER_DRAIN = false; static_assert(ACT == 0 || ACT == 1, "EpiBf16: ACT is 0 (none) or 1 (gelu_pk)");
    bf16_t* O; int ldc; const float* bias; int split_cols; size_t split_stride; float scale0;
    __device__ __forceinline__ void operator()(const f32x4 (&acc)[2][2][4][2], const Unit& u, int wr, int wc, int fr, int fq) const {
        const int row0 = u.pm * BM + wr * 64 + fr; int colt = u.pn * BM; bf16_t* base = O;
        float sc = 1.f; if (split_cols) { const int t = colt / split_cols; base += (size_t)t * split_stride; colt -= t * split_cols; if (t == 0) sc = scale0; }
        const int col0 = colt + wc * 32 + 8 * fq, bcol0 = u.pn * BM + wc * 32 + 8 * fq;
        f32x4 bv[2][2];
#pragma unroll
        for (int bj = 0; bj < 2; ++bj)
#pragma unroll
            for (int n = 0; n < 2; ++n) bv[bj][n] = bias ? *(const f32x4*)(bias + bcol0 + bj * HALF + 4 * n) : (f32x4){0.f, 0.f, 0.f, 0.f};
#pragma unroll
        for (int ai = 0; ai < 2; ++ai)
#pragma unroll
            for (int m = 0; m < 4; ++m) { bf16_t* rowp = base + (size_t)(row0 + ai * HALF + m * 16) * ldc + col0;
#pragma unroll
                for (int bj = 0; bj < 2; ++bj) { f32x4 v0 = acc[ai][bj][m][0] + bv[bj][0], v1 = acc[ai][bj][m][1] + bv[bj][1];
                    if (ACT == 1) { f32x2 a = gelu_pk((f32x2){v0[0], v0[1]}), b = gelu_pk((f32x2){v0[2], v0[3]}), c = gelu_pk((f32x2){v1[0], v1[1]}), d = gelu_pk((f32x2){v1[2], v1[3]});
                        v0 = (f32x4){a.x, a.y, b.x, b.y}; v1 = (f32x4){c.x, c.y, d.x, d.y}; }
                    v0 = v0 * sc; v1 = v1 * sc; u32x4 w; w.x = cvt_pk_bf16(v0[0], v0[1]); w.y = cvt_pk_bf16(v0[2], v0[3]); w.z = cvt_pk_bf16(v1[0], v1[1]); w.w = cvt_pk_bf16(v1[2], v1[3]);
                    *(u32x4*)(rowp + bj * HALF) = w; } }
    }
};

struct PanelOrder {
    int nM, nN, G, c;
    __host__ __device__ void init(int M, int N, int G_, int c_) { nM = M / BM; nN = N / BM; G = G_; c = c_; }
    __host__ __device__ bool next(int i, Unit& u) const { const int pm = c + (i / nN) * G; if (pm >= nM) return false; u.pm = pm; u.pn = i % nN; return true; }
    __device__ __forceinline__ void a_ready(const Unit&) const {}
    __device__ __forceinline__ void done(const Unit&) const {}
};

__device__ __forceinline__ float fast_sigmoid(float x) { return __builtin_amdgcn_rcpf(1.0f + __builtin_amdgcn_exp2f(-1.4426950408889634f * x)); }
__device__ __forceinline__ float fast_silu(float x) { return x * fast_sigmoid(x); }
__device__ __forceinline__ u32x4 pack8(const f32x4& v0, const f32x4& v1) { u32x4 w; w.x = cvt_pk_bf16(v0[0], v0[1]); w.y = cvt_pk_bf16(v0[2], v0[3]); w.z = cvt_pk_bf16(v1[0], v1[1]); w.w = cvt_pk_bf16(v1[2], v1[3]); return w; }
__device__ __forceinline__ f32x4 rope4(const f32x4& x, const f32x4& t) { return (f32x4){x[0] * t[0] - x[1] * t[1], x[1] * t[0] + x[0] * t[1], x[2] * t[2] - x[3] * t[3], x[3] * t[2] + x[2] * t[3]}; }
constexpr int LDC = 1024;
constexpr int HM_ROWS = 2048 + 17;
__device__ __forceinline__ size_t hm_base(int pm, int h) { return ((size_t)((pm >> 3) * 8 + h) * HM_ROWS + (size_t)(pm & 7) * 256) * 128; }

struct EpiL0 {
    static constexpr bool PERM = true, AFTER_DRAIN = false;
    bf16_t* QS; bf16_t* LF; bf16_t* VV; bf16_t* GS; const float* lb;
    __device__ __forceinline__ void operator()(const f32x4 (&acc)[2][2][4][2], const Unit& u, int wr, int wc, int fr, int fq) const {
        const int type = u.pn >> 2;
        bf16_t* base = type == 0 ? QS : (type == 1 ? LF : (type == 2 ? VV : GS));
        const int col0 = (u.pn & 3) * BM + wc * 32 + 8 * fq;
        bf16_t* hb = base + hm_base(u.pm, 2 * (u.pn & 3));
        f32x4 lbv[2][2];
#pragma unroll
        for (int bj = 0; bj < 2; ++bj)
#pragma unroll
            for (int n = 0; n < 2; ++n) lbv[bj][n] = (type == 1) ? *(const f32x4*)(lb + col0 + bj * HALF + 4 * n) : (f32x4){0.f, 0.f, 0.f, 0.f};
#pragma unroll
        for (int ai = 0; ai < 2; ++ai)
#pragma unroll
            for (int m = 0; m < 4; ++m) { bf16_t* rowp = hb + (unsigned)((wr * 64 + fr + ai * HALF + m * 16) * 128 + 32 * wc + 8 * fq);
#pragma unroll
                for (int bj = 0; bj < 2; ++bj) { f32x4 v[2] = {acc[ai][bj][m][0], acc[ai][bj][m][1]};
                    if (type == 0 || type == 3) {
#pragma unroll
                        for (int n = 0; n < 2; ++n)
#pragma unroll
                            for (int e = 0; e < 4; ++e) v[n][e] = fast_silu(v[n][e]);
                    } else if (type == 1) {
#pragma unroll
                        for (int n = 0; n < 2; ++n)
#pragma unroll
                            for (int e = 0; e < 4; ++e) { const float l = lbv[bj][n][e];
                                const float k = (1.0f - l) * __builtin_amdgcn_rcpf(1.0f + __builtin_amdgcn_exp2f(1.4426950408889634f * v[n][e]));
                                v[n][e] = k < 0.5f ? k : k - 1.0f; }
                    }
                    __builtin_nontemporal_store(pack8(v[0], v[1]), (u32x4*)(rowp + (size_t)bj * HM_ROWS * 128)); } }
    }
};

struct EpiKV {
    static constexpr bool PERM = true, AFTER_DRAIN = false;
    bf16_t* KB; bf16_t* VB; const int* pos; const float* tab; float* KM;
    __device__ __forceinline__ void operator()(const f32x4 (&acc)[2][2][4][2], const Unit& u, int wr, int wc, int fr, int fq) const {
        const int type = u.pn >> 2;
        const int row0 = u.pm * BM + wr * 64 + fr, col0 = (u.pn & 3) * BM + wc * 32 + 8 * fq;
        if (type == 1) {
#pragma unroll
            for (int ai = 0; ai < 2; ++ai)
#pragma unroll
                for (int m = 0; m < 4; ++m) { bf16_t* rowp = VB + hm_base(u.pm, 2 * (u.pn & 3)) + (unsigned)((wr * 64 + fr + ai * HALF + m * 16) * 128 + 32 * wc + 8 * fq);
#pragma unroll
                    for (int bj = 0; bj < 2; ++bj) __builtin_nontemporal_store(pack8(acc[ai][bj][m][0], acc[ai][bj][m][1]), (u32x4*)(rowp + (size_t)bj * HM_ROWS * 128)); }
        } else {
            f32x4 cs[2][2];
#pragma unroll
            for (int bj = 0; bj < 2; ++bj)
#pragma unroll
                for (int n = 0; n < 2; ++n) cs[bj][n] = (f32x4){0.f, 0.f, 0.f, 0.f};
#pragma unroll
            for (int ai = 0; ai < 2; ++ai)
#pragma unroll
                for (int m = 0; m < 4; ++m) { const int row = row0 + ai * HALF + m * 16; int p = pos[row]; p = p < 0 ? 0 : (p > 4095 ? 4095 : p);
                    const float* tp = tab + ((size_t)p * 64 + 16 * wc + 4 * fq) * 2; const f32x4 t0 = *(const f32x4*)tp, t1 = *(const f32x4*)(tp + 4);
                    bf16_t* rowp = KB + hm_base(u.pm, 2 * (u.pn & 3)) + (unsigned)((wr * 64 + fr + ai * HALF + m * 16) * 128 + 32 * wc + 8 * fq);
#pragma unroll
                    for (int bj = 0; bj < 2; ++bj) { const f32x4 r0 = rope4(acc[ai][bj][m][0], t0), r1 = rope4(acc[ai][bj][m][1], t1);
                        cs[bj][0] += r0; cs[bj][1] += r1; __builtin_nontemporal_store(pack8(r0, r1), (u32x4*)(rowp + (size_t)bj * HM_ROWS * 128)); } }
#pragma unroll
            for (int bj = 0; bj < 2; ++bj)
#pragma unroll
                for (int n = 0; n < 2; ++n)
#pragma unroll
                    for (int e = 0; e < 4; ++e) { float s = cs[bj][n][e]; s += __shfl_xor(s, 1); s += __shfl_xor(s, 2); s += __shfl_xor(s, 4); s += __shfl_xor(s, 8); cs[bj][n][e] = s; }
            if (fr == 0) { const int b = u.pm >> 3, blk = u.pm & 7;
#pragma unroll
                for (int bj = 0; bj < 2; ++bj) { const int h = 2 * (u.pn & 3) + bj; float* kp = KM + ((size_t)(((b * 8 + h) * 8 + blk) * 2 + wr)) * 128 + 32 * wc + 8 * fq;
                    *(f32x4*)kp = cs[bj][0]; *(f32x4*)(kp + 4) = cs[bj][1]; } }
        }
    }
};

struct EpiQZ {
    static constexpr bool PERM = true, AFTER_DRAIN = false;
    bf16_t* QB; bf16_t* ZS; const int* pos; const float* tab; float qscale;
    __device__ __forceinline__ void operator()(const f32x4 (&acc)[2][2][4][2], const Unit& u, int wr, int wc, int fr, int fq) const {
        const int type = u.pn >> 2;
        const int row0 = u.pm * BM + wr * 64 + fr, col0 = (u.pn & 3) * BM + wc * 32 + 8 * fq;
        if (type == 1) {
#pragma unroll
            for (int ai = 0; ai < 2; ++ai)
#pragma unroll
                for (int m = 0; m < 4; ++m) { bf16_t* rowp = ZS + (size_t)(row0 + ai * HALF + m * 16) * LDC + col0;
#pragma unroll
                    for (int bj = 0; bj < 2; ++bj) { f32x4 v[2] = {acc[ai][bj][m][0], acc[ai][bj][m][1]};
#pragma unroll
                        for (int n = 0; n < 2; ++n)
#pragma unroll
                            for (int e = 0; e < 4; ++e) v[n][e] = fast_silu(v[n][e]);
                        *(u32x4*)(rowp + bj * HALF) = pack8(v[0], v[1]); } }
        } else {
            int pp[8];
#pragma unroll
            for (int i = 0; i < 8; ++i) { int p = pos[row0 + (i >> 2) * HALF + (i & 3) * 16]; pp[i] = p < 0 ? 0 : (p > 4095 ? 4095 : p); }
#pragma unroll
            for (int ai = 0; ai < 2; ++ai) { f32x4 t0[4], t1[4];
#pragma unroll
                for (int m = 0; m < 4; ++m) { const float* tp = tab + ((size_t)pp[ai * 4 + m] * 64 + 16 * wc + 4 * fq) * 2; t0[m] = *(const f32x4*)tp; t1[m] = *(const f32x4*)(tp + 4); }
#pragma unroll
                for (int m = 0; m < 4; ++m) { const int row = row0 + ai * HALF + m * 16;
                    bf16_t* rowp = QB + (size_t)row * LDC + col0;
#pragma unroll
                    for (int bj = 0; bj < 2; ++bj) *(u32x4*)(rowp + bj * HALF) = pack8(rope4(acc[ai][bj][m][0], t0[m] * qscale), rope4(acc[ai][bj][m][1], t1[m] * qscale)); }
                asm volatile("" ::: "memory"); }
        }
    }
};
template <class Epi, class Sched, bool ALIGN_EPI = false, bool SP2 = false>
__device__ __forceinline__ void gemm_phase(PG8_LAS unsigned char* lds, const Gemm g, const Sched& S, const Epi& E) {
    int tid_ = threadIdx.x; asm volatile("" : "+v"(tid_));
    const int tid = tid_, wid = __builtin_amdgcn_readfirstlane(tid >> 6), lane = tid & 63, wr = wid >> 2, wc = wid & 3, fr = lane & 15, fq = lane >> 4;
    const int K = g.K, nt = K / BK;
    unsigned voffA[2], voffB[2];
#pragma unroll
    for (int i = 0; i < 2; ++i) { int R, C; stage_rc(tid * 16 + i * 8192, R, C); const int Rb = Epi::PERM ? ((R & ~31) + perm32(R & 31)) : R;
        voffA[i] = (unsigned)(R * K + C) * 2u; voffB[i] = (unsigned)(Rb * K + C) * 2u; }
    const size_t kstep = (size_t)(BK * 2);
    const size_t hstep = (size_t)HALF * K * 2;
    const size_t tstep = 2 * hstep;
    const unsigned ldsw = (unsigned)wid * 1024u;
    const int aoff = lds_byte(wr * 64 + fr, fq * 8), boff = lds_byte(wc * 32 + fr, fq * 8);
#define PG8_SA(b, h) (((b) * 2 + (h)) * HTB)
#define PG8_SB(b, h) ((4 + (b) * 2 + (h)) * HTB)
#define PG8_STAGE(bufoff, gbase, voff) do { _Pragma("unroll") for (int _i = 0; _i < 2; ++_i) \
        __builtin_amdgcn_global_load_lds((const unsigned*)((const char*)(gbase) + (voff)[_i]), (PG8_LAS unsigned*)(lds + (bufoff) + ldsw + _i * 8192), 16, 0, 0); } while (0)
#define PG8_LDA(dst, b, h) do { _Pragma("unroll") for (int m = 0; m < 4; ++m) _Pragma("unroll") for (int k = 0; k < 2; ++k) dst[m][k] = *(const PG8_LAS bf16x8*)(lds + PG8_SA(b, h) + aoff + m * 2048 + k * 1024); } while (0)
#define PG8_LDB(dst, b, h) do { _Pragma("unroll") for (int n = 0; n < 2; ++n) _Pragma("unroll") for (int k = 0; k < 2; ++k) dst[n][k] = *(const PG8_LAS bf16x8*)(lds + PG8_SB(b, h) + boff + n * 2048 + k * 1024); } while (0)
#define PG8_MMA(ai, bj, At, Bt) do { __builtin_amdgcn_s_setprio(1); _Pragma("unroll") for (int m = 0; m < 4; ++m) _Pragma("unroll") for (int n = 0; n < 2; ++n) _Pragma("unroll") for (int k = 0; k < 2; ++k) \
        acc[ai][bj][m][n] = __builtin_amdgcn_mfma_f32_16x16x32_bf16(Bt[n][k], At[m][k], acc[ai][bj][m][n], 0, 0, 0); __builtin_amdgcn_s_setprio(0); } while (0)
#define PG8_WAIT_V(n) asm volatile("s_waitcnt vmcnt(" #n ")" ::: "memory")
#define PG8_WAIT_L(n) asm volatile("s_waitcnt lgkmcnt(" #n ")" ::: "memory")
#define PG8_BAR __builtin_amdgcn_s_barrier()
#define PG8_SCHED __builtin_amdgcn_sched_barrier(0)
    Unit cur, nxt; int ui = 0;
    if (!S.next(0, cur)) return;
    f32x4 acc[2][2][4][2];
#pragma unroll
    for (int a = 0; a < 2; ++a)
#pragma unroll
        for (int b = 0; b < 2; ++b)
#pragma unroll
            for (int m = 0; m < 4; ++m)
#pragma unroll
                for (int n = 0; n < 2; ++n) acc[a][b][m][n] = (f32x4){0.f, 0.f, 0.f, 0.f};
    bf16x8 At[4][2], B0[2][2], B1[2][2];
    const char* cA = (const char*)g.A + (size_t)cur.pm * tstep; const char* cB = (const char*)g.Bt + (size_t)cur.pn * tstep;
    S.a_ready(cur);
    if constexpr (SP2) {
        PG8_STAGE(PG8_SB(0, 0), cB, voffB); PG8_STAGE(PG8_SB(0, 1), cB + hstep, voffB); PG8_STAGE(PG8_SA(0, 0), cA, voffA); PG8_STAGE(PG8_SA(0, 1), cA + hstep, voffA);
        if (wr == 1) PG8_BAR;
        PG8_WAIT_V(2); PG8_BAR;
        PG8_STAGE(PG8_SB(1, 0), cB + kstep, voffB); PG8_STAGE(PG8_SA(1, 0), cA + kstep, voffA); PG8_STAGE(PG8_SB(1, 1), cB + hstep + kstep, voffB);
        PG8_WAIT_V(6); PG8_BAR;
    } else {
        PG8_STAGE(PG8_SB(0, 0), cB, voffB); PG8_STAGE(PG8_SA(0, 0), cA, voffA); PG8_STAGE(PG8_SB(0, 1), cB + hstep, voffB); PG8_STAGE(PG8_SA(0, 1), cA + hstep, voffA);
        if (wr == 1) PG8_BAR;
        PG8_WAIT_V(4); PG8_BAR;
        PG8_STAGE(PG8_SB(1, 0), cB + kstep, voffB); PG8_STAGE(PG8_SA(1, 0), cA + kstep, voffA); PG8_STAGE(PG8_SB(1, 1), cB + hstep + kstep, voffB);
        PG8_WAIT_V(6); PG8_BAR;
    }
    for (;;) {
        const bool has_next = S.next(ui + 1, nxt);
        const char* nA = has_next ? (const char*)g.A + (size_t)nxt.pm * tstep : cA; const char* nB = has_next ? (const char*)g.Bt + (size_t)nxt.pn * tstep : cB;
        for (int t = 0; t < nt; t += 2) {
            const bool last = (t == nt - 2);
            const char* a1 = cA + (size_t)(t + 1) * kstep;
            const char* a2 = last ? nA : cA + (size_t)(t + 2) * kstep; const char* b2 = last ? nB : cB + (size_t)(t + 2) * kstep;
            const char* a3 = a2 + kstep; const char* b3 = b2 + kstep;
            if (last && has_next) S.a_ready(nxt);
            if constexpr (SP2) {
            PG8_LDB(B0, 0, 0); PG8_LDB(B1, 0, 1); PG8_SCHED; PG8_LDA(At, 0, 0); PG8_STAGE(PG8_SA(1, 1), a1 + hstep, voffA);
            PG8_WAIT_V(8); PG8_WAIT_L(0); PG8_BAR; PG8_MMA(0, 0, At, B0); PG8_MMA(0, 1, At, B1); PG8_BAR; PG8_SCHED;
            PG8_LDA(At, 0, 1); PG8_STAGE(PG8_SB(0, 0), b2, voffB); PG8_STAGE(PG8_SB(0, 1), b2 + hstep, voffB); PG8_STAGE(PG8_SA(0, 0), a2, voffA);
            PG8_WAIT_V(8); PG8_WAIT_L(0); PG8_BAR; PG8_MMA(1, 0, At, B0); PG8_MMA(1, 1, At, B1); PG8_BAR; PG8_SCHED;
            PG8_LDB(B0, 1, 0); PG8_LDB(B1, 1, 1); PG8_SCHED; PG8_LDA(At, 1, 0); PG8_STAGE(PG8_SA(0, 1), a2 + hstep, voffA);
            PG8_WAIT_V(8); PG8_WAIT_L(0); PG8_BAR; PG8_MMA(0, 0, At, B0); PG8_MMA(0, 1, At, B1); PG8_BAR; PG8_SCHED;
            PG8_LDA(At, 1, 1); PG8_STAGE(PG8_SB(1, 0), b3, voffB); PG8_STAGE(PG8_SB(1, 1), b3 + hstep, voffB); PG8_STAGE(PG8_SA(1, 0), a3, voffA);
            PG8_WAIT_V(8); PG8_WAIT_L(0); PG8_BAR; PG8_MMA(1, 0, At, B0); PG8_MMA(1, 1, At, B1); PG8_BAR; PG8_SCHED;
            } else {
            PG8_LDB(B0, 0, 0); PG8_SCHED; PG8_LDA(At, 0, 0); PG8_STAGE(PG8_SA(1, 1), a1 + hstep, voffA);
            PG8_WAIT_L(8); PG8_BAR; PG8_WAIT_L(0); PG8_MMA(0, 0, At, B0); PG8_BAR; PG8_SCHED;
            PG8_LDB(B1, 0, 1); PG8_STAGE(PG8_SB(0, 0), b2, voffB);
            PG8_BAR; PG8_WAIT_L(0); PG8_MMA(0, 1, At, B1); PG8_BAR;
            PG8_LDA(At, 0, 1); PG8_STAGE(PG8_SA(0, 0), a2, voffA);
            PG8_BAR; PG8_WAIT_L(0); PG8_MMA(1, 0, At, B0); PG8_BAR; PG8_SCHED;
            PG8_STAGE(PG8_SB(0, 1), b2 + hstep, voffB);
            PG8_WAIT_V(6); PG8_BAR; PG8_MMA(1, 1, At, B1); PG8_BAR;
            PG8_LDB(B0, 1, 0); PG8_SCHED; PG8_LDA(At, 1, 0); PG8_STAGE(PG8_SA(0, 1), a2 + hstep, voffA);
            PG8_WAIT_L(8); PG8_BAR; PG8_WAIT_L(0); PG8_MMA(0, 0, At, B0); PG8_BAR; PG8_SCHED;
            PG8_LDB(B1, 1, 1); PG8_STAGE(PG8_SB(1, 0), b3, voffB);
            PG8_BAR; PG8_WAIT_L(0); PG8_MMA(0, 1, At, B1); PG8_BAR;
            PG8_LDA(At, 1, 1); PG8_STAGE(PG8_SA(1, 0), a3, voffA);
            PG8_BAR; PG8_WAIT_L(0); PG8_MMA(1, 0, At, B0); PG8_BAR; PG8_SCHED;
            PG8_STAGE(PG8_SB(1, 1), b3 + hstep, voffB);
            PG8_WAIT_V(6); PG8_BAR; PG8_MMA(1, 1, At, B1); PG8_BAR;
            }
        }
        if constexpr (ALIGN_EPI) { if (wr == 0) PG8_BAR; }
        if constexpr (!Epi::AFTER_DRAIN) { E(acc, cur, wr, wc, fr, fq); S.done(cur); }
        if (!has_next) break;
#pragma unroll
        for (int a = 0; a < 2; ++a)
#pragma unroll
            for (int b = 0; b < 2; ++b)
#pragma unroll
                for (int m = 0; m < 4; ++m)
#pragma unroll
                    for (int n = 0; n < 2; ++n) acc[a][b][m][n] = (f32x4){0.f, 0.f, 0.f, 0.f};
        cur = nxt; cA = nA; cB = nB; ++ui;
        if constexpr (ALIGN_EPI) { if (wr == 1) PG8_BAR; }
    }
    PG8_WAIT_V(0);
    if constexpr (!ALIGN_EPI) { if (wr == 0) PG8_BAR; }
    PG8_BAR;
    if constexpr (Epi::AFTER_DRAIN) { E.fused(acc, cur, wr, wc, fr, fq, lds, wid, lane); S.done(cur); }
#undef PG8_SA
#undef PG8_SB
#undef PG8_STAGE
#undef PG8_LDA
#undef PG8_LDB
#undef PG8_MMA
#undef PG8_WAIT_V
#undef PG8_WAIT_L
#undef PG8_BAR
#undef PG8_SCHED
}
}

constexpr int NWAVES = 8;
constexpr int BATCH = 32, SEQ = 2048, DM = 1024, M = BATCH * SEQ;
constexpr int NH = 8, HD = 128;
constexpr float NORM_EPS = 1e-6f;
constexpr float LOG2E = 1.4426950408889634f;
constexpr float QSCALE = 0.08838834764831845f * 1.4426950408889634f;
constexpr int NPH = 10;
#ifndef MK_N_LAUNCHES
#define MK_N_LAUNCHES 1
#endif
constexpr int N_LAUNCHES = MK_N_LAUNCHES;

constexpr size_t MiB = 1u << 20;
constexpr size_t WS_CTL = 0, CTL_ZERO_BYTES = 32768;
constexpr size_t WS_WIN0 = 2 * MiB, WS_WOUT0 = 10 * MiB, WS_WKV = 12 * MiB, WS_WIN1 = 16 * MiB, WS_WOUT1 = 20 * MiB;
constexpr size_t WS_MOD = 22 * MiB;
constexpr size_t WS_LB = 23 * MiB;
constexpr size_t WS_TAB = 24 * MiB;
constexpr size_t WS_KM = 26 * MiB;
constexpr size_t WS_ACT = 32 * MiB, SLOT = 130 * MiB;
constexpr size_t WS_S0 = WS_ACT, WS_S1 = WS_ACT + SLOT, WS_S2 = WS_ACT + 2 * SLOT, WS_S3 = WS_ACT + 3 * SLOT, WS_S4 = WS_ACT + 4 * SLOT, WS_S5 = WS_ACT + 5 * SLOT, WS_S6 = WS_ACT + 6 * SLOT;
constexpr size_t WS_END = WS_ACT + 7 * SLOT;
constexpr int CW_BAR = 4096;

constexpr int RING_BYTES = 131072;
constexpr int LDSCTL_OFF = 143360, MISC_OFF = LDSCTL_OFF + 320;
constexpr int LDS_BYTES = 147456;

#define GAS __attribute__((address_space(1)))
#define LAS __attribute__((address_space(3)))
typedef unsigned short bf16;
typedef unsigned u32x4 __attribute__((ext_vector_type(4)));
typedef unsigned u32x2 __attribute__((ext_vector_type(2)));
typedef float f32x4 __attribute__((ext_vector_type(4)));
typedef float f32x2 __attribute__((ext_vector_type(2)));
typedef short bf16x8 __attribute__((ext_vector_type(8)));
typedef short s16x4 __attribute__((ext_vector_type(4)));
typedef GAS unsigned gu32;
#define RLX_AGENT __ATOMIC_RELAXED, __HIP_MEMORY_SCOPE_AGENT
#define MFMA16(a, b, c) __builtin_amdgcn_mfma_f32_16x16x32_bf16((a), (b), (c), 0, 0, 0)
__device__ __forceinline__ unsigned pk2(float lo, float hi) { return pg8::cvt_pk_bf16(lo, hi); }
__device__ __forceinline__ float bflo(unsigned w) { return __uint_as_float(w << 16); }
__device__ __forceinline__ float bfhi(unsigned w) { return __uint_as_float(w & 0xffff0000u); }
__device__ __forceinline__ float bf2f(bf16 h) { return __uint_as_float((unsigned)h << 16); }
__device__ __forceinline__ bf16 f2bf(float f) { return (bf16)(pk2(f, 0.f) & 0xffffu); }
__device__ __forceinline__ float ex2(float x) { return __builtin_amdgcn_exp2f(x); }
template <int CTRL> __device__ __forceinline__ float dppf(float x) { return __builtin_bit_cast(float, __builtin_amdgcn_mov_dpp(__builtin_bit_cast(int, x), CTRL, 0xf, 0xf, true)); }
__device__ __forceinline__ float wave_sum(float v) {
    v += dppf<0xB1>(v); v += dppf<0x4E>(v); v += dppf<0x141>(v); v += dppf<0x140>(v);
    { auto s = __builtin_amdgcn_permlane16_swap(__float_as_uint(v), __float_as_uint(v), false, false); v = __uint_as_float(s[0]) + __uint_as_float(s[1]); }
    { auto t = __builtin_amdgcn_permlane32_swap(__float_as_uint(v), __float_as_uint(v), false, false); v = __uint_as_float(t[0]) + __uint_as_float(t[1]); }
    return v;
}

#define XB_TMO      128
#define XB_XCNT(j)  (256  + 64 * (j))
#define XB_XSUB(j)  (1280 + 64 * (j))
#define XB_XGEN(j)  (2304 + 64 * (j))
#define XB_TOP      3328
#define XB_TOPGEN   3392
#define XCD_BAR_WORDS 3456
#define XB_SPIN_CAP (1u << 18)

__device__ __forceinline__ unsigned xb_ld(unsigned* p)              { return __hip_atomic_load(p, __ATOMIC_RELAXED, __HIP_MEMORY_SCOPE_AGENT); }
__device__ __forceinline__ unsigned xb_add(unsigned* p, unsigned v) { return __hip_atomic_fetch_add(p, v, __ATOMIC_RELAXED, __HIP_MEMORY_SCOPE_AGENT); }
__device__ __forceinline__ unsigned xb_xcc_id() { return (unsigned)__builtin_amdgcn_s_getreg((3 << 11) | 20) & 0xFu; }
#define XB_SPIN(cond, bar) do { unsigned _sp = 0; while (cond) { __builtin_amdgcn_s_sleep(1); \
    if ((++_sp & 255u) == 0u) { if (xb_ld(&(bar)[XB_TMO])) break; if (_sp > XB_SPIN_CAP) { atomicAdd(&(bar)[XB_TMO], 1u); break; } } } } while (0)

struct XcdBarrier { unsigned* bar; unsigned x; volatile LAS unsigned* st; };
__device__ __forceinline__ XcdBarrier xcd_barrier_post(unsigned* bar, volatile LAS unsigned* st) {
    XcdBarrier b; b.bar = bar; b.x = xb_xcc_id(); b.st = st;
    if (threadIdx.x == 0) (void)xb_add(&bar[XB_XCNT(b.x)], 1u);
    return b;
}
__device__ __forceinline__ void xcd_barrier_complete(unsigned* bar, unsigned x, unsigned& nloc, unsigned& nx) {
    const unsigned G = gridDim.x * gridDim.y * gridDim.z;
    unsigned sum, cnt, mine, sp = 0u;
    for (;;) {
        sum = 0u; cnt = 0u; mine = 0u;
#pragma unroll
        for (unsigned j = 0; j < 16; ++j) { const unsigned c = xb_ld(&bar[XB_XCNT(j)]); sum += c; cnt += (c > 0u) ? 1u : 0u; mine = (j == x) ? c : mine; }
        if (sum == G) break;
        __builtin_amdgcn_s_sleep(1);
        if ((++sp & 255u) == 0u) { if (xb_ld(&bar[XB_TMO])) break; if (sp > XB_SPIN_CAP) { atomicAdd(&bar[XB_TMO], 1u); break; } }
    }
    nloc = mine > 0u ? mine : 1u; nx = cnt > 0u ? cnt : 1u;
}
__device__ __forceinline__ void xcd_barrier(const XcdBarrier& b) {
    asm volatile("s_waitcnt vmcnt(0)" ::: "memory");
    __syncthreads();
    if (threadIdx.x == 0) {
        unsigned* bar = b.bar;
        __builtin_amdgcn_s_waitcnt(0);
        unsigned nloc = b.st[0], nx = b.st[1];
        if (nloc == 0u) { xcd_barrier_complete(bar, b.x, nloc, nx); b.st[0] = nloc; b.st[1] = nx; }
        const unsigned old = xb_add(&bar[XB_XSUB(b.x)], 1u);
        const unsigned gen = old / nloc;
        if (old + 1u == (gen + 1u) * nloc) {
            __builtin_amdgcn_fence(__ATOMIC_RELEASE, "agent");
            asm volatile("s_waitcnt vmcnt(0)" ::: "memory");
            const unsigned og = xb_add(&bar[XB_TOP], 1u);
            const unsigned tg = og / nx;
            if (og + 1u == (tg + 1u) * nx) xb_add(&bar[XB_TOPGEN], 1u);
            else XB_SPIN(xb_ld(&bar[XB_TOPGEN]) == tg, bar);
            __builtin_amdgcn_fence(__ATOMIC_ACQUIRE, "agent");
            xb_add(&bar[XB_XGEN(b.x)], 1u);
            asm volatile("s_waitcnt vmcnt(0)" ::: "memory");
        } else {
            XB_SPIN(xb_ld(&bar[XB_XGEN(b.x)]) == gen, bar);
            __builtin_amdgcn_fence(__ATOMIC_ACQUIRE, "agent");
            asm volatile("s_waitcnt vmcnt(0)" ::: "memory");
        }
    }
    __syncthreads();
}

struct Frame {
    LAS unsigned char* lds;
    int tid, lane, wave;
    int vcu, G;
    const float *x, *c, *mod_w, *mod_b, *pre_g, *post_g, *a_w_in, *a_w_out, *a_gn, *a_lb, *kv_g, *w_kv, *b_w_in, *b_w_out;
    const int* pos;
    float* out;
    bf16 *Win0, *Wout0, *Wkv, *Win1, *Wout1;
    float *MOD, *LB, *TAB, *KM;
    bf16 *S0, *S1, *S2, *S3, *S4, *S5, *S6;
};

__device__ __forceinline__ int rope_row(int n) { const int h = n >> 7, d = n & 127; return (h << 7) + ((d & 63) << 1) + (d >> 6); }
__device__ __forceinline__ void p0_transpose_item(const float* W, int K, int N, bf16* WT, int perm_cols, LAS float* scr, int item, int lane) {
    const int nblk = N / 32, kb = item / nblk, nb = item % nblk, k0 = 64 * kb, n0 = 32 * nb;
#pragma unroll 8
    for (int i = 0; i < 32; ++i) { const int kk = 2 * i + (lane >> 5); scr[kk * 33 + (lane & 31)] = W[(size_t)(k0 + kk) * N + n0 + (lane & 31)]; }
    asm volatile("s_waitcnt lgkmcnt(0)" ::: "memory");
    const int c = lane & 7;
#pragma unroll
    for (int j = 0; j < 4; ++j) { const int n = (lane >> 3) + 8 * j; const LAS float* s = scr + (8 * c) * 33 + n;
        u32x4 o; o.x = pk2(s[0 * 33], s[1 * 33]); o.y = pk2(s[2 * 33], s[3 * 33]); o.z = pk2(s[4 * 33], s[5 * 33]); o.w = pk2(s[6 * 33], s[7 * 33]);
        const int nn = n0 + n, dr = nn < perm_cols ? rope_row(nn) : nn;
        *(GAS u32x4*)(WT + (size_t)dr * K + k0 + 8 * c) = o; }
    asm volatile("s_waitcnt lgkmcnt(0)" ::: "memory");
}
__device__ __forceinline__ void rope_cs(int pos, int i, float& co, float& si) {
    double inv = 1.0, bs = 0.8659643233600653;
    for (int e = i; e > 0; e >>= 1) { if (e & 1) inv *= bs; bs *= bs; }
    const float ang = (float)pos * (float)inv;
    const double x = (double)ang, kq = __builtin_rint(x * 0.6366197723675814);
    double r = __builtin_fma(-kq, 1.5707963267948966, x); r = __builtin_fma(-kq, 6.123233995736766e-17, r);
    const double r2 = r * r;
    const double sp = r * (1.0 + r2 * (-1.0 / 6 + r2 * (1.0 / 120 + r2 * (-1.0 / 5040 + r2 * (1.0 / 362880 + r2 * (-1.0 / 39916800 + r2 * (1.0 / 6227020800.0)))))));
    const double cp = 1.0 + r2 * (-0.5 + r2 * (1.0 / 24 + r2 * (-1.0 / 720 + r2 * (1.0 / 40320 + r2 * (-1.0 / 3628800 + r2 * (1.0 / 479001600 + r2 * (-1.0 / 87178291200.0)))))));
    const int q = ((int)kq) & 3;
    const double cc = (q == 0) ? cp : (q == 1) ? -sp : (q == 2) ? -cp : sp;
    const double ss = (q == 0) ? sp : (q == 1) ? cp : (q == 2) ? -sp : -cp;
    co = (float)cc; si = (float)ss;
}
__device__ __forceinline__ void p0_modulation_item(Frame& F, int item) {
    const int l = item / 96, n0 = (item % 96) * 32, tid = F.tid;
    LAS float* sc = (LAS float*)F.lds;
#pragma unroll 1
    for (int base = 0; base < 32768; base += 512 * 16) {
        float v[16];
#pragma unroll
        for (int u = 0; u < 16; ++u) v[u] = F.c[base + u * 512 + tid];
#pragma unroll
        for (int u = 0; u < 16; ++u) { const int idx = base + u * 512 + tid, b = idx >> 10, k = idx & 1023; sc[k * 32 + b] = v[u] / (1.0f + __expf(-v[u])); }
    }
    __syncthreads();
    const int col = tid & 31, ks = tid >> 5;
    float acc[32];
#pragma unroll
    for (int b = 0; b < 32; ++b) acc[b] = 0.f;
    const float* w = F.mod_w + (size_t)l * 1024 * 3072 + n0 + col;
#pragma unroll 1
    for (int i0 = 0; i0 < 64; i0 += 16) {
        float wv[16];
#pragma unroll
        for (int u = 0; u < 16; ++u) wv[u] = w[(size_t)(ks + 16 * (i0 + u)) * 3072];
#pragma unroll
        for (int u = 0; u < 16; ++u) { const int k = ks + 16 * (i0 + u); const LAS f32x4* s4 = (const LAS f32x4*)(sc + k * 32);
#pragma unroll
            for (int b4 = 0; b4 < 8; ++b4) { const f32x4 sv = s4[b4]; acc[4 * b4 + 0] += sv[0] * wv[u]; acc[4 * b4 + 1] += sv[1] * wv[u]; acc[4 * b4 + 2] += sv[2] * wv[u]; acc[4 * b4 + 3] += sv[3] * wv[u]; } }
    }
    __syncthreads();
    LAS float* red = sc;
#pragma unroll
    for (int b = 0; b < 32; ++b) red[(ks * 32 + b) * 32 + col] = acc[b];
    __syncthreads();
    for (int o = tid; o < 1024; o += 512) { const int b = o >> 5, cc = o & 31; float s = 0.f;
#pragma unroll
        for (int k2 = 0; k2 < 16; ++k2) s += red[(k2 * 32 + b) * 32 + cc];
        F.MOD[(size_t)(l * 32 + b) * 3072 + n0 + cc] = s + F.mod_b[l * 3072 + n0 + cc]; }
    __syncthreads();
}
__device__ __forceinline__ void p0_prologue(Frame& F) {
    for (int it = F.vcu; it < 192; it += F.G) p0_modulation_item(F, it);
    const int gt = F.vcu * 512 + F.tid, NGT = F.G * 512;
    for (int d = gt; d < 1024; d += NGT) F.LB[d] = 1.0f / (1.0f + __expf(F.a_lb[1024 + d] - F.a_lb[d]));
    for (int idx = gt; idx < 4096 * 64; idx += NGT) { float co, si; rope_cs(idx >> 6, idx & 63, co, si); *(f32x2*)(F.TAB + (size_t)idx * 2) = (f32x2){co, si}; }
    LAS float* scr = (LAS float*)(F.lds + F.wave * 16384);
    const int gw = F.vcu * NWAVES + F.wave, NGW = F.G * NWAVES;
    constexpr int I_IN0 = 16 * 128, I_OUT = 16 * 32, I_KV = 16 * 64;
    constexpr int NITEMS = I_IN0 + 2 * I_OUT + 2 * I_KV;
    for (int it = gw; it < NITEMS; it += NGW) {
        int r = it;
        if (r < I_IN0) { p0_transpose_item(F.a_w_in, 1024, 4096, F.Win0, 0, scr, r, F.lane); continue; } r -= I_IN0;
        if (r < I_OUT) { p0_transpose_item(F.a_w_out, 1024, 1024, F.Wout0, 0, scr, r, F.lane); continue; } r -= I_OUT;
        if (r < I_KV) { p0_transpose_item(F.w_kv, 1024, 2048, F.Wkv, 1024, scr, r, F.lane); continue; } r -= I_KV;
        if (r < I_KV) { p0_transpose_item(F.b_w_in, 1024, 2048, F.Win1, 1024, scr, r, F.lane); continue; } r -= I_KV;
        p0_transpose_item(F.b_w_out, 1024, 1024, F.Wout1, 0, scr, r, F.lane);
    }
}

constexpr int RS = 1;
__device__ __forceinline__ void p1_modnorm(Frame& F) {
    const int gw = F.vcu * NWAVES + F.wave, NGW = F.G * NWAVES, lane = F.lane;
    const int nit = (M - gw + NGW - 1) / NGW;
    f32x4 G[4];
#pragma unroll
    for (int j = 0; j < 4; ++j) G[j] = *(const f32x4*)(F.pre_g + 4 * lane + 256 * j);
    f32x4 xr[4][4], sc[4], sh[4], scn[4], shn[4];
#define P1_ROW(it_) ((size_t)(nit - 1 - (it_)) * NGW + gw)
#define P1_XLOAD(slot, it_) do { const GAS f32x4* xp_ = (const GAS f32x4*)(F.x + P1_ROW(it_) * DM) + lane; _Pragma("unroll") for (int j = 0; j < 4; ++j) xr[slot][j] = __builtin_nontemporal_load(xp_ + 64 * j); } while (0)
#define P1_CLOAD(SC, SH, it_) do { const float* mod_ = F.MOD + (size_t)(P1_ROW(it_) / SEQ) * 3072 + 4 * lane; _Pragma("unroll") for (int j = 0; j < 4; ++j) { SC[j] = *(const f32x4*)(mod_ + 1024 + 256 * j); SH[j] = *(const f32x4*)(mod_ + 256 * j); } } while (0)
#define P1_STEP(slot, it_) do { if ((it_) < nit) { \
        if ((it_) + 1 < nit) P1_CLOAD(scn, shn, (it_) + 1); \
        float ss = 0.f; _Pragma("unroll") for (int j = 0; j < 4; ++j) { const f32x4 v = xr[slot][j]; ss += (v[0] * v[0] + v[1] * v[1]) + (v[2] * v[2] + v[3] * v[3]); } \
        const float rstd = 1.0f / sqrtf(wave_sum(ss) * (1.0f / DM) + NORM_EPS); \
        GAS u32x2* o8 = (GAS u32x2*)(F.S0 + P1_ROW(it_) * DM) + lane; \
        _Pragma("unroll") for (int j = 0; j < 4; ++j) { const f32x4 u = xr[slot][j] * rstd * (G[j] * (1.0f + sc[j])) + sh[j]; o8[64 * j] = (u32x2){pk2(u[0], u[1]), pk2(u[2], u[3])}; } \
        if ((it_) + 4 < nit) P1_XLOAD(slot, (it_) + 4); \
        _Pragma("unroll") for (int j = 0; j < 4; ++j) { sc[j] = scn[j]; sh[j] = shn[j]; } } } while (0)
    if (nit > 0) { P1_CLOAD(sc, sh, 0); }
#pragma unroll
    for (int q = 0; q < 4; ++q) if (q < nit) P1_XLOAD(q, q);
#pragma unroll 1
    for (int it0 = 0; it0 < nit; it0 += 4) { P1_STEP(0, it0); P1_STEP(1, it0 + 1); P1_STEP(2, it0 + 2); P1_STEP(3, it0 + 3); }
#undef P1_XLOAD
#undef P1_ROW
#undef P1_CLOAD
#undef P1_STEP
}
__device__ __forceinline__ void p5_mid(Frame& F) {
    const int gw = F.vcu * NWAVES + F.wave, NGW = F.G * NWAVES, lane = F.lane;
    for (int rb = gw; rb < M / 32; rb += NGW) {
        const int row0 = rb * 32, b = row0 / SEQ;
        const float* mod0 = F.MOD + (size_t)b * 3072; const float* mod1 = F.MOD + (size_t)(32 + b) * 3072;
        f32x4 G0[4], A1[4], B1[4], KG[4];
#pragma unroll
        for (int j = 0; j < 4; ++j) { const int c = 4 * lane + 256 * j;
            G0[j] = *(const f32x4*)(mod0 + 2048 + c) * *(const f32x4*)(F.post_g + c);
            A1[j] = *(const f32x4*)(F.pre_g + 1024 + c) * (1.0f + *(const f32x4*)(mod1 + 1024 + c)); B1[j] = *(const f32x4*)(mod1 + c); KG[j] = *(const f32x4*)(F.kv_g + c); }
        const GAS f32x4* xb = (const GAS f32x4*)(F.x + (size_t)row0 * DM) + lane; const GAS u32x2* yb = (const GAS u32x2*)(F.S6 + (size_t)row0 * DM) + lane;
        f32x4 cx[2][4], nx[2][4]; u32x2 cy[2][4], ny[2][4];
#pragma unroll
        for (int q = 0; q < 2; ++q)
#pragma unroll
            for (int j = 0; j < 4; ++j) { cx[q][j] = __builtin_nontemporal_load(xb + (size_t)(RS * q) * (DM / 4) + 64 * j); cy[q][j] = yb[(size_t)(RS * q) * (DM / 4) + 64 * j]; }
#pragma unroll 1
        for (int r = 0; r < 32; r += 2) {
            if (r + 2 < 32) {
#pragma unroll
                for (int q = 0; q < 2; ++q)
#pragma unroll
                    for (int j = 0; j < 4; ++j) { nx[q][j] = __builtin_nontemporal_load(xb + (size_t)(RS * (r + 2 + q)) * (DM / 4) + 64 * j); ny[q][j] = yb[(size_t)(RS * (r + 2 + q)) * (DM / 4) + 64 * j]; }
            }
#pragma unroll
            for (int q = 0; q < 2; ++q) {
                const size_t ro = (size_t)(row0 + RS * (r + q)) * DM;
                f32x4 v[4], y[4]; float ss = 0.f;
#pragma unroll
                for (int j = 0; j < 4; ++j) { v[j] = cx[q][j]; const u32x2 yw = cy[q][j]; y[j] = (f32x4){bflo(yw.x), bfhi(yw.x), bflo(yw.y), bfhi(yw.y)};
                    ss += (y[j][0] * y[j][0] + y[j][1] * y[j][1]) + (y[j][2] * y[j][2] + y[j][3] * y[j][3]); }
                const float rstd = 1.0f / sqrtf(wave_sum(ss) * (1.0f / DM) + NORM_EPS);
                float s2 = 0.f;
                GAS u32x2* ho = (GAS u32x2*)(F.out + ro) + lane;
#pragma unroll
                for (int j = 0; j < 4; ++j) { v[j] = v[j] + G0[j] * (y[j] * rstd); __builtin_nontemporal_store((u32x2){pk2(v[j][0], v[j][1]), pk2(v[j][2], v[j][3])}, ho + 64 * j); s2 += (v[j][0] * v[j][0] + v[j][1] * v[j][1]) + (v[j][2] * v[j][2] + v[j][3] * v[j][3]); }
                const float rstd1 = 1.0f / sqrtf(wave_sum(s2) * (1.0f / DM) + NORM_EPS);
                GAS u32x2* uo = (GAS u32x2*)(F.S0 + ro) + lane; GAS u32x2* ko = (GAS u32x2*)(F.S1 + ro) + lane;
#pragma unroll
                for (int j = 0; j < 4; ++j) { const f32x4 hn = v[j] * rstd1; const f32x4 u = hn * A1[j] + B1[j], k = hn * KG[j];
                    uo[64 * j] = (u32x2){pk2(u[0], u[1]), pk2(u[2], u[3])}; ko[64 * j] = (u32x2){pk2(k[0], k[1]), pk2(k[2], k[3])}; }
            }
#pragma unroll
            for (int q = 0; q < 2; ++q)
#pragma unroll
                for (int j = 0; j < 4; ++j) { cx[q][j] = nx[q][j]; cy[q][j] = ny[q][j]; }
        }
    }
}
__device__ __forceinline__ void p9_final(Frame& F) {
    const int gw = F.vcu * NWAVES + F.wave, NGW = F.G * NWAVES, lane = F.lane;
    for (int rb = gw; rb < M / 32; rb += NGW) {
        const int row0 = rb * 32, b = row0 / SEQ;
        const float* mod1 = F.MOD + (size_t)(32 + b) * 3072;
        f32x4 G1[4];
#pragma unroll
        for (int j = 0; j < 4; ++j) { const int c = 4 * lane + 256 * j; G1[j] = *(const f32x4*)(mod1 + 2048 + c) * *(const f32x4*)(F.post_g + 1024 + c); }
        GAS f32x4* hb = (GAS f32x4*)(F.out + (size_t)row0 * DM) + lane; const GAS u32x2* yb = (const GAS u32x2*)(F.S0 + (size_t)row0 * DM) + lane;
        const GAS u32x2* hq = (const GAS u32x2*)(F.out + (size_t)row0 * DM) + lane;
        u32x2 ch[2][4], nh[2][4]; u32x2 cy[2][4], ny[2][4];
#pragma unroll
        for (int q = 0; q < 2; ++q)
#pragma unroll
            for (int j = 0; j < 4; ++j) { ch[q][j] = hq[(size_t)(RS * q) * (DM / 2) + 64 * j]; cy[q][j] = yb[(size_t)(RS * q) * (DM / 4) + 64 * j]; }
#pragma unroll 1
        for (int r = 0; r < 32; r += 2) {
            if (r + 2 < 32) {
#pragma unroll
                for (int q = 0; q < 2; ++q)
#pragma unroll
                    for (int j = 0; j < 4; ++j) { nh[q][j] = hq[(size_t)(RS * (r + 2 + q)) * (DM / 2) + 64 * j]; ny[q][j] = yb[(size_t)(RS * (r + 2 + q)) * (DM / 4) + 64 * j]; }
            }
#pragma unroll
            for (int q = 0; q < 2; ++q) {
                f32x4 y[4]; float ss = 0.f;
#pragma unroll
                for (int j = 0; j < 4; ++j) { const u32x2 yw = cy[q][j]; y[j] = (f32x4){bflo(yw.x), bfhi(yw.x), bflo(yw.y), bfhi(yw.y)};
                    ss += (y[j][0] * y[j][0] + y[j][1] * y[j][1]) + (y[j][2] * y[j][2] + y[j][3] * y[j][3]); }
                const float rstd = 1.0f / sqrtf(wave_sum(ss) * (1.0f / DM) + NORM_EPS);
#pragma unroll
                for (int j = 0; j < 4; ++j) { const u32x2 hw = ch[q][j]; const f32x4 hv = (f32x4){bflo(hw.x), bfhi(hw.x), bflo(hw.y), bfhi(hw.y)}; __builtin_nontemporal_store(hv + G1[j] * (y[j] * rstd), hb + (size_t)(RS * (r + q)) * (DM / 4) + 64 * j); }
            }
#pragma unroll
            for (int q = 0; q < 2; ++q)
#pragma unroll
                for (int j = 0; j < 4; ++j) { ch[q][j] = nh[q][j]; cy[q][j] = ny[q][j]; }
        }
    }
}


__device__ __forceinline__ void p3_recurrence3(Frame& F) {
    LAS unsigned char* L = F.lds;
    constexpr int SET = 38400, O_QH = 0, O_KH = 8704, O_KLT = 17408, O_VT = 27648, O_EBL = 37888;
    constexpr int O_ATT = 2 * SET, O_PART = O_ATT + 2560, O_OB = O_PART + 4096;
    const int tid = F.tid, lane = F.lane, w = F.wave, g = lane >> 4, c16 = lane & 15;
    const bf16* QS = F.S1; const bf16* LF = F.S2; const bf16* VV = F.S3; const bf16* GS = F.S4; bf16* O0 = F.S5;
    const f32x4 ZERO4 = (f32x4){0.f, 0.f, 0.f, 0.f};
    const int dp = tid & 63, tq = tid >> 6;
    const int pd = (((2 * dp) & ~31) | ((((2 * dp) >> 2) & 3) << 3) | ((((2 * dp) >> 4) & 1) << 2) | ((2 * dp) & 3)) * 2;
    for (int bh = F.vcu; bh < BATCH * NH; bh += F.G) {
        const int b = bh >> 3, h = bh & 7;
        const size_t rbase = (size_t)b * SEQ;
        f32x4 S[8];
#pragma unroll
        for (int dt = 0; dt < 8; ++dt) S[dt] = ZERO4;
        const size_t hbase = (size_t)bh * pg8::HM_ROWS * HD;
        const char* qs_b = (const char*)(QS + hbase); const char* lf_b = (const char*)(LF + hbase); const char* vv_b = (const char*)(VV + hbase); const char* gs_b = (const char*)(GS + hbase); bf16* o0_u = O0 + rbase * DM + h * HD;
        asm volatile("" : "+s"(qs_b), "+s"(lf_b), "+s"(vv_b), "+s"(gs_b));
        const unsigned lo0 = (unsigned)((4 * tq) * HD + 2 * dp);
        const unsigned go0 = (unsigned)((4 * w + (lane >> 4)) * DM + (lane & 15) * 8);
        const unsigned gi0 = (unsigned)((4 * w + (lane >> 4)) * HD + (lane & 15) * 8);
        const f32x4 gn0 = *(const f32x4*)(F.a_gn + 8 * (lane & 15)), gn1 = *(const f32x4*)(F.a_gn + 8 * (lane & 15) + 4);
        unsigned rq[4], rl[4], rv[4], nq[4], nl[4], nv[4]; u32x4 gsr, gsn = (u32x4){0u, 0u, 0u, 0u};
        float kk0[4], kk1[4], cs0[4], cs1[4];
#define R3_LOAD(c, Q, Lq, V) do { const unsigned cx_ = (unsigned)((c) * 32 * HD * 2) + 2u * lo0; _Pragma("unroll") for (int i_ = 0; i_ < 4; ++i_) { \
        Q[i_] = __builtin_nontemporal_load((const GAS unsigned*)(qs_b + (cx_ + i_ * HD * 2))); Lq[i_] = __builtin_nontemporal_load((const GAS unsigned*)(lf_b + (cx_ + i_ * HD * 2))); V[i_] = __builtin_nontemporal_load((const GAS unsigned*)(vv_b + (cx_ + i_ * HD * 2))); } } while (0)
#define R3_WALK(RL) do { float r0_ = 1.f, r1_ = 1.f; _Pragma("unroll") for (int i_ = 0; i_ < 4; ++i_) { const float a0 = bflo(RL[i_]), a1 = bfhi(RL[i_]); \
        const float f0 = a0 >= 0.f ? 1.0f - a0 : -a0, f1 = a1 >= 0.f ? 1.0f - a1 : -a1; kk0[i_] = a0 >= 0.f ? a0 : 1.0f + a0; kk1[i_] = a1 >= 0.f ? a1 : 1.0f + a1; \
        r0_ *= f0; r1_ *= f1; cs0[i_] = r0_; cs1[i_] = r1_; } *(LAS f32x2*)(L + O_PART + (tq * 128 + 2 * dp) * 4) = (f32x2){r0_, r1_}; } while (0)
#define R3_PREP(set, RQ, RV) do { LAS unsigned char* B_ = L + (set) * SET; f32x2 pre = (f32x2){1.f, 1.f}, tot = (f32x2){1.f, 1.f}; \
        _Pragma("unroll") for (int p_ = 0; p_ < 8; ++p_) { const f32x2 v_ = *(const LAS f32x2*)(L + O_PART + (p_ * 128 + 2 * dp) * 4); tot *= v_; if (p_ < tq) pre *= v_; } \
        float ka_[4], kb_[4]; \
        _Pragma("unroll") for (int i_ = 0; i_ < 4; ++i_) { const int t_ = 4 * tq + i_; const float eb0 = pre[0] * cs0[i_], eb1 = pre[1] * cs1[i_]; \
            const float kh0 = kk0[i_] * __builtin_amdgcn_rcpf(eb0), kh1 = kk1[i_] * __builtin_amdgcn_rcpf(eb1); \
            *(LAS unsigned*)(B_ + O_QH + t_ * 272 + pd) = pk2(bflo(RQ[i_]) * eb0, bfhi(RQ[i_]) * eb1); *(LAS unsigned*)(B_ + O_KH + t_ * 272 + pd) = pk2(kh0, kh1); ka_[i_] = kh0 * tot[0]; kb_[i_] = kh1 * tot[1]; } \
        *(LAS u32x2*)(B_ + O_KLT + (2 * dp) * 80 + tq * 8) = (u32x2){pk2(ka_[0], ka_[1]), pk2(ka_[2], ka_[3])}; *(LAS u32x2*)(B_ + O_KLT + (2 * dp + 1) * 80 + tq * 8) = (u32x2){pk2(kb_[0], kb_[1]), pk2(kb_[2], kb_[3])}; \
        *(LAS u32x2*)(B_ + O_VT + (2 * dp) * 80 + tq * 8) = (u32x2){(RV[0] & 0xffffu) | (RV[1] << 16), (RV[2] & 0xffffu) | (RV[3] << 16)}; \
        *(LAS u32x2*)(B_ + O_VT + (2 * dp + 1) * 80 + tq * 8) = (u32x2){(RV[0] >> 16) | (RV[1] & 0xffff0000u), (RV[2] >> 16) | (RV[3] & 0xffff0000u)}; \
        if (tq == 0) *(LAS f32x2*)(B_ + O_EBL + (2 * dp) * 4) = tot; } while (0)
        R3_LOAD(0, rq, rl, rv); gsr = __builtin_nontemporal_load((const GAS u32x4*)(gs_b + 2u * gi0)); R3_LOAD(1, nq, nl, nv);
        R3_WALK(rl);
        __syncthreads();
        R3_PREP(0, rq, rv);
        R3_LOAD(2, rq, rl, rv);
        __syncthreads();
        auto r3_iter = [&](const int it, unsigned (&XQ)[4], unsigned (&XL)[4], unsigned (&XV)[4]) __attribute__((always_inline)) {
            const LAS unsigned char* C_ = L + (it & 1) * SET;
            const bool more = it + 1 < SEQ / 32;
            if (more) R3_WALK(XL);
            if (w < 3) {
                const int tt = (w + 1) >> 1, st = w >> 1;
                f32x4 a = ZERO4;
#pragma unroll
                for (int ks = 0; ks < 4; ++ks) { const bf16x8 qa = *(const LAS bf16x8*)(C_ + O_QH + (16 * tt + c16) * 272 + ks * 64 + g * 16), kb = *(const LAS bf16x8*)(C_ + O_KH + (16 * st + c16) * 272 + ks * 64 + g * 16);
                    a = MFMA16(qa, kb, a); }
#pragma unroll
                for (int r = 0; r < 4; ++r) { const int t = 16 * tt + 4 * g + r, s = 16 * st + c16; *(LAS bf16*)(L + O_ATT + t * 80 + s * 2) = f2bf(s <= t ? a[r] : 0.f); }
            } else if (w == 3) {
#pragma unroll
                for (int r = 0; r < 4; ++r) { const int t = 4 * g + r, s = 16 + c16; *(LAS bf16*)(L + O_ATT + t * 80 + s * 2) = (bf16)0; }
            }
            __syncthreads();
            if (more) { R3_PREP((it + 1) & 1, XQ, XV); if (it + 3 < SEQ / 32) R3_LOAD(it + 3, XQ, XL, XV); gsn = __builtin_nontemporal_load((const GAS u32x4*)(gs_b + ((unsigned)((it + 1) * 32 * HD * 2) + 2u * gi0))); }
            {
                const bf16x8 bV = *(const LAS bf16x8*)(C_ + O_VT + (16 * w + c16) * 80 + g * 16);
                f32x4 o[2];
#pragma unroll
                for (int tt = 0; tt < 2; ++tt) { const bf16x8 aA = *(const LAS bf16x8*)(L + O_ATT + (16 * tt + c16) * 80 + g * 16); o[tt] = MFMA16(aA, bV, ZERO4); }
#pragma unroll
                for (int ks = 0; ks < 4; ++ks) {
                    const u32x4 sw = (u32x4){pk2(S[2 * ks][0], S[2 * ks][1]), pk2(S[2 * ks][2], S[2 * ks][3]), pk2(S[2 * ks + 1][0], S[2 * ks + 1][1]), pk2(S[2 * ks + 1][2], S[2 * ks + 1][3])};
                    const bf16x8 bS = __builtin_bit_cast(bf16x8, sw);
#pragma unroll
                    for (int tt = 0; tt < 2; ++tt) { const bf16x8 aQ = *(const LAS bf16x8*)(C_ + O_QH + (16 * tt + c16) * 272 + ks * 64 + g * 16); o[tt] = MFMA16(aQ, bS, o[tt]); } }
#pragma unroll
                for (int dt = 0; dt < 8; ++dt) { const f32x4 e4 = *(const LAS f32x4*)(C_ + O_EBL + (16 * dt + 4 * g) * 4); const bf16x8 aK = *(const LAS bf16x8*)(C_ + O_KLT + (16 * dt + c16) * 80 + g * 16);
                    S[dt] = MFMA16(aK, bV, S[dt] * e4); }
#pragma unroll
                for (int tt = 0; tt < 2; ++tt)
#pragma unroll
                    for (int r = 0; r < 4; ++r) ((LAS float*)(L + O_OB))[(16 * tt + 4 * g + r) * 132 + 16 * w + c16] = o[tt][r];
            }
            __syncthreads();
            {
                const LAS unsigned char* op = L + O_OB + (((4 * w + (lane >> 4)) * 132) + (lane & 15) * 8) * 4;
                const f32x4 a = *(const LAS f32x4*)op, b_ = *(const LAS f32x4*)(op + 16);
                float ss = (a[0] * a[0] + a[1] * a[1]) + (a[2] * a[2] + a[3] * a[3]) + (b_[0] * b_[0] + b_[1] * b_[1]) + (b_[2] * b_[2] + b_[3] * b_[3]);
                ss += dppf<0xB1>(ss); ss += dppf<0x4E>(ss); ss += dppf<0x141>(ss); ss += dppf<0x140>(ss);
                const float rstd = 1.0f / sqrtf(ss * (1.0f / HD) + NORM_EPS);
                const u32x4 gs = gsr; const f32x4 an = a * rstd * gn0, bn = b_ * rstd * gn1;
                u32x4 w_; w_.x = pk2(an[0] * bflo(gs.x), an[1] * bfhi(gs.x)); w_.y = pk2(an[2] * bflo(gs.y), an[3] * bfhi(gs.y)); w_.z = pk2(bn[0] * bflo(gs.z), bn[1] * bfhi(gs.z)); w_.w = pk2(bn[2] * bflo(gs.w), bn[3] * bfhi(gs.w));
                *(GAS u32x4*)(o0_u + ((unsigned)(it * 32 * DM) + go0)) = w_;
                gsr = gsn;
            }
        };
        for (int it2 = 0; it2 < SEQ / 32; it2 += 2) { r3_iter(it2, nq, nl, nv); r3_iter(it2 + 1, rq, rl, rv); }
#undef R3_LOAD
#undef R3_WALK
#undef R3_PREP
        __syncthreads();
    }
}

namespace at2 {
typedef float f32x16 __attribute__((ext_vector_type(16)));
#define AT_KSWZ(row, colB) ((row) * 256 + ((colB) ^ (((row) & 7) << 4)))
#define AT_SBAR() __builtin_amdgcn_sched_barrier(0)
constexpr int SHM_V = 16384, SHM_K = 16384;
constexpr float THRL = 11.5f;
#ifndef AT_SDEPTH
#define AT_SDEPTH 2
#endif
__device__ __forceinline__ int crow(int r, int hi) { return (r & 3) + 8 * (r >> 2) + 4 * hi; }
__device__ __forceinline__ u32x2 split3(float x) {
    const unsigned w0 = pk2(x, 0.f) & 0xffffu; const float r1 = x - __uint_as_float(w0 << 16);
    const unsigned w1 = pk2(r1, 0.f) & 0xffffu; const float r2 = r1 - __uint_as_float(w1 << 16);
    const unsigned w2 = pk2(r2, 0.f) & 0xffffu;
    return (u32x2){w0 | (w1 << 16), w2};
}
template <bool FIRST> __device__ __forceinline__ void partialSM(f32x16& p0, f32x16& p1, float& m_reg, float& alpha, u32x2& qm, bool diag, int thr_in, int hi) {
    const float NEG = -__builtin_inff();
    if (diag) { int thr = thr_in; asm volatile("" : "+v"(thr));
#pragma unroll
        for (int r = 0; r < 16; ++r) { const int c = (r & 3) + 8 * (r >> 2); if (c > thr) p0[r] = NEG; if (c + 32 > thr) p1[r] = NEG; }
    }
    float pmax = p0[0];
#pragma unroll
    for (int r = 1; r < 16; ++r) pmax = fmaxf(pmax, p0[r]);
#pragma unroll
    for (int r = 0; r < 16; ++r) pmax = fmaxf(pmax, p1[r]);
    { auto rr = __builtin_amdgcn_permlane32_swap(__float_as_uint(pmax), __float_as_uint(pmax), false, false);
      pmax = fmaxf(__uint_as_float(rr[0]), __uint_as_float(rr[1])); }
    if (!FIRST && __builtin_expect(__all(pmax <= THRL), 1)) { alpha = 1.f; }
    else { const float d = FIRST ? pmax : fmaxf(pmax, 0.f);
        alpha = FIRST ? 1.f : __builtin_amdgcn_exp2f(-d); m_reg = FIRST ? d : m_reg + d;
#pragma unroll
        for (int r = 0; r < 16; ++r) { p0[r] -= d; p1[r] -= d; }
        const u32x2 s3 = split3(-m_reg); qm.x = hi ? 0u : s3.x; qm.y = hi ? 0u : s3.y; }
#pragma unroll
    for (int r = 0; r < 16; ++r) p0[r] = __builtin_amdgcn_exp2f(p0[r]);
    asm volatile("" : "+v"(p0), "+v"(p1));
}
__device__ __forceinline__ void finishSM(f32x16& p0, f32x16& p1, float alpha, float& l_reg, bf16x8& pa0, bf16x8& pa1, bf16x8& pa2, bf16x8& pa3) {
#pragma unroll
    for (int r = 0; r < 16; ++r) p1[r] = __builtin_amdgcn_exp2f(p1[r]);
    float ps = 0.f;
#pragma unroll
    for (int r = 0; r < 16; ++r) ps += p0[r];
#pragma unroll
    for (int r = 0; r < 16; ++r) ps += p1[r];
    { auto rr = __builtin_amdgcn_permlane32_swap(__float_as_uint(ps), __float_as_uint(ps), false, false);
      ps = __uint_as_float(rr[0]) + __uint_as_float(rr[1]); }
    l_reg = l_reg * alpha + ps;
#define AT_PK4(P, BASE, OUT) do { const u32x4 w_ = {pk2(P[BASE + 0], P[BASE + 1]), pk2(P[BASE + 2], P[BASE + 3]), pk2(P[BASE + 4], P[BASE + 5]), pk2(P[BASE + 6], P[BASE + 7])}; \
    OUT = __builtin_bit_cast(bf16x8, w_); } while (0)
    AT_PK4(p0, 0, pa0); AT_PK4(p0, 8, pa1); AT_PK4(p1, 0, pa2); AT_PK4(p1, 8, pa3);
#undef AT_PK4
}
template <int OFF> __device__ __forceinline__ bf16x8 k_read(int a) {
    bf16x8 r; asm volatile("ds_read_b128 %0, %1 offset:%2" : "=&v"(r) : "v"(a), "i"(OFF) : "memory"); return r;
}
__device__ __forceinline__ void qkt(f32x16& p0, f32x16& p1, const LAS unsigned char* Ks, const int (&kb)[4], const bf16x8* qr, u32x2 qme) {
    const int k0 = (int)(unsigned)(uintptr_t)Ks;
    const int a0 = k0 + kb[0], a1 = k0 + kb[1], a2 = k0 + kb[2], a3 = k0 + kb[3];
#define AT_KRD(F, a) do { F[0] = k_read<0>(a); F[1] = k_read<8192>(a); F[2] = k_read<128>(a); F[3] = k_read<8320>(a); } while (0)
#define AT_KMM(F, i) do { p0 = __builtin_amdgcn_mfma_f32_32x32x16_bf16(F[0], qr[i], p0, 0, 0, 0); p1 = __builtin_amdgcn_mfma_f32_32x32x16_bf16(F[1], qr[i], p1, 0, 0, 0); \
        p0 = __builtin_amdgcn_mfma_f32_32x32x16_bf16(F[2], qr[(i) + 4], p0, 0, 0, 0); p1 = __builtin_amdgcn_mfma_f32_32x32x16_bf16(F[3], qr[(i) + 4], p1, 0, 0, 0); } while (0)
    bf16x8 fa[4], fb[4];
    AT_KRD(fa, a0); AT_KRD(fb, a1);
    f32x16 z;
#pragma unroll
    for (int r = 0; r < 16; ++r) z[r] = 0.f;
    const s16x4 ones = __builtin_bit_cast(s16x4, (u32x2){0x3F803F80u, 0x3F803F80u}), qb = __builtin_bit_cast(s16x4, qme);
    p0 = __builtin_amdgcn_mfma_f32_32x32x8bf16_1k(ones, qb, z, 0, 0, 0);
    p1 = p0; AT_SBAR();
    asm volatile("s_waitcnt lgkmcnt(4)" ::: "memory"); AT_SBAR(); AT_KMM(fa, 0); AT_SBAR(); AT_KRD(fa, a2);
    asm volatile("s_waitcnt lgkmcnt(4)" ::: "memory"); AT_SBAR(); AT_KMM(fb, 1); AT_SBAR(); AT_KRD(fb, a3);
    asm volatile("s_waitcnt lgkmcnt(4)" ::: "memory"); AT_SBAR(); AT_KMM(fa, 2); AT_SBAR();
    asm volatile("s_waitcnt lgkmcnt(0)" ::: "memory"); AT_SBAR(); AT_KMM(fb, 3);
#undef AT_KRD
#undef AT_KMM
}
__device__ __forceinline__ int v_st(int k, int c) { return ((k >> 3) * 4 + (c >> 5)) * 512 + ((k & 7) * 32 + (c & 31)) * 2; }
__device__ __forceinline__ int v_rd_base(int lane) { return ((lane & 3) << 3) | (((lane >> 2) & 3) << 6) | (((lane >> 4) & 1) << 5) | (((lane >> 5) & 1) << 8); }
constexpr int v_rd_off(int d0, int ks, int half) { return d0 * 512 + ks * 4096 + half * 2048; }
template <int OFF> __device__ __forceinline__ s16x4 tr_read(int vb) {
    s16x4 r; asm volatile("ds_read_b64_tr_b16 %0, %1 offset:%2" : "=&v"(r) : "v"(vb), "i"(OFF) : "memory"); return r;
}
template <int D0> __device__ __forceinline__ void pv_one(f32x16& od, int vb, bf16x8 pa0, bf16x8 pa1, bf16x8 pa2, bf16x8 pa3) {
    const s16x4 l0 = tr_read<v_rd_off(D0, 0, 0)>(vb), h0 = tr_read<v_rd_off(D0, 0, 1)>(vb), l1 = tr_read<v_rd_off(D0, 1, 0)>(vb), h1 = tr_read<v_rd_off(D0, 1, 1)>(vb);
    const s16x4 l2 = tr_read<v_rd_off(D0, 2, 0)>(vb), h2 = tr_read<v_rd_off(D0, 2, 1)>(vb), l3 = tr_read<v_rd_off(D0, 3, 0)>(vb), h3 = tr_read<v_rd_off(D0, 3, 1)>(vb);
    asm volatile("s_waitcnt lgkmcnt(0)" ::: "memory"); AT_SBAR();
#define AT_PK(Lo, Hi) (bf16x8){Lo[0], Lo[1], Lo[2], Lo[3], Hi[0], Hi[1], Hi[2], Hi[3]}
    od = __builtin_amdgcn_mfma_f32_32x32x16_bf16(pa0, AT_PK(l0, h0), od, 0, 0, 0);
    od = __builtin_amdgcn_mfma_f32_32x32x16_bf16(pa1, AT_PK(l1, h1), od, 0, 0, 0);
    od = __builtin_amdgcn_mfma_f32_32x32x16_bf16(pa2, AT_PK(l2, h2), od, 0, 0, 0);
    od = __builtin_amdgcn_mfma_f32_32x32x16_bf16(pa3, AT_PK(l3, h3), od, 0, 0, 0);
#undef AT_PK
}
__device__ __forceinline__ void pv_d0(f32x16* o, int vb, bf16x8 pa0, bf16x8 pa1, bf16x8 pa2, bf16x8 pa3) {
    pv_one<0>(o[0], vb, pa0, pa1, pa2, pa3); pv_one<1>(o[1], vb, pa0, pa1, pa2, pa3); pv_one<2>(o[2], vb, pa0, pa1, pa2, pa3); pv_one<3>(o[3], vb, pa0, pa1, pa2, pa3);
}
}

template <bool LEAD> __device__ __forceinline__ void p7_body(Frame& F) {
    using namespace at2;
    LAS unsigned char* L = F.lds;
    constexpr int O_K = 0, O_V = 4 * SHM_K, O_WS = 4 * SHM_K + 4 * SHM_V, O_KM = O_WS + 2048, O_OST = O_K + 2 * SHM_K;
    const int tid = F.tid, lane = F.lane, wid = F.wave, r32 = lane & 31, hi = lane >> 5;
    const bf16* QB = F.S4; const bf16* KB = F.S2; const bf16* VB = F.S3; const bf16* ZS = F.S5; bf16* A1 = F.S6;
    const float NEG_INF = -__builtin_inff();
    LAS float* li_l = (LAS float*)(L + O_WS) + wid * 64; LAS float* al_l = li_l + 32;
    const int vb0 = (int)(unsigned)(uintptr_t)(L + O_V) + v_rd_base(lane);
    int kb[4];
    { int r_ = lane; asm volatile("" : "+v"(r_)); const int rr_ = r_ & 31, base_ = rr_ * 256 + ((((r_ >> 5) ^ rr_) & 1) << 4), x_ = (rr_ >> 1) & 3;
#pragma unroll
      for (int i = 0; i < 4; ++i) kb[i] = base_ + ((i ^ x_) << 5); }
    unsigned kvo0, kvo1, vvo;
    { int ln_ = lane; asm volatile("" : "+v"(ln_));
      const int rq = ln_ >> 4, cx = ln_ & 15;
      kvo0 = (unsigned)((8 * wid + rq) * 256 + ((cx ^ rq) << 4));
      kvo1 = (unsigned)((8 * wid + 4 + rq) * 256 + ((cx ^ (4 + rq)) << 4));
      const int key = 8 * wid + ((ln_ >> 2) & 7);
      vvo = (unsigned)(key * 256 + (ln_ >> 5) * 64 + (ln_ & 3) * 16); }
    const int ngrp = F.G / 4, mem = F.vcu & 3, bh0 = F.vcu >> 2;
    const int nun = (ngrp > 0 && bh0 < BATCH * NH) ? 2 * ((BATCH * NH - bh0 + ngrp - 1) / ngrp) : 0;
    bf16x8 qr[8];
#define AT_UBH(u) (bh0 + ((u) >> 1) * ngrp)
#define AT_UJ(u) (((u) & 1) ? 7 - mem : mem)
#define AT_KROW(bhv, jv, t) ((size_t)(bhv) * pg8::HM_ROWS + (size_t)(((t) < 4) ? (jv) : (((t) - 4) >> 2)) * 256 + (size_t)((t) & 3) * 64)
#define AT_DMA(sb, bhv, jv, t) do { const size_t k0_ = AT_KROW(bhv, jv, t) * HD; const char* vt_ = (const char*)(VB + k0_); const char* kt_ = (const char*)(KB + k0_); \
    __builtin_amdgcn_global_load_lds((const unsigned*)(kt_ + kvo0), (LAS unsigned*)(L + O_K + (sb) + wid * 2048), 16, 0, 0); \
    __builtin_amdgcn_global_load_lds((const unsigned*)(kt_ + kvo1), (LAS unsigned*)(L + O_K + (sb) + wid * 2048 + 1024), 16, 0, 0); \
    __builtin_amdgcn_global_load_lds((const unsigned*)(vt_ + vvo), (LAS unsigned*)(L + O_V + (sb) + wid * 2048), 16, 0, 0); \
    __builtin_amdgcn_global_load_lds((const unsigned*)(vt_ + 128 + vvo), (LAS unsigned*)(L + O_V + (sb) + wid * 2048 + 1024), 16, 0, 0); } while (0)
#define AT_BAR(N) do { AT_SBAR(); asm volatile("s_waitcnt vmcnt(" #N ")" ::: "memory"); __builtin_amdgcn_s_barrier(); AT_SBAR(); } while (0)
#define AT_RESC(a) do { if (__any((a) < 1.f)) { if (hi == 0) al_l[r32] = (a); asm volatile("s_waitcnt lgkmcnt(0)" ::: "memory"); \
    _Pragma("unroll") for (int d_ = 0; d_ < 4; ++d_) _Pragma("unroll") for (int r_ = 0; r_ < 16; ++r_) o[d_][r_] *= al_l[crow(r_, hi)]; } } while (0)
#define AT_PSM(P0, P1, AL, t) partialSM<false>(P0, P1, m_reg, AL, qm, (t) < 4 && ((t) & 3) == (wid >> 1), qrel - (64 * ((t) & 3) + 4 * hi), hi)
#define AT_QME(t) ({ const bool rs_ = ((t) < 4) ? (((t) & 3) <= (wid >> 1)) : (((mk >> (((t) - 4) >> 2)) & 1u) != 0u); (u32x2){rs_ ? qm.x : negpk, rs_ ? qm.y : 0u}; })
#define AT_UNIT_REQ(u) do { const int bhn_ = AT_UBH(u), jn_ = AT_UJ(u); const bf16* qn_ = QB + ((size_t)(bhn_ >> 3) * SEQ + (size_t)jn_ * 256) * DM + (bhn_ & 7) * HD; \
    int ln_ = lane; asm volatile("" : "+v"(ln_)); const unsigned qo_ = (unsigned)((32 * wid + (ln_ & 31)) * DM + (ln_ >> 5) * 8); \
    _Pragma("unroll") for (int d0 = 0; d0 < 8; ++d0) qr[d0] = *(const GAS bf16x8*)(qn_ + (qo_ + d0 * 16)); \
    AT_DMA(0, bhn_, jn_, 0); AT_DMA(SHM_K, bhn_, jn_, 1); \
 } while (0)
#define AT_KM_REQ(u) do { const int bhn_ = AT_UBH(u); _Pragma("unroll") for (int i_ = 0; i_ < 2; ++i_) { const int e_ = tid + 512 * i_; const float* kp_ = F.KM + ((size_t)(bhn_ * 8 + (e_ >> 7)) * 2) * 128 + (e_ & 127); kma[i_] = kp_[0]; kmb[i_] = kp_[128]; } } while (0)
    float kms[2] = {0.f, 0.f};
    if (nun > 0) { float kma[2], kmb[2]; AT_UNIT_REQ(0); AT_KM_REQ(0); kms[0] = kma[0] + kmb[0]; kms[1] = kma[1] + kmb[1]; }
    for (int u = 0; u < nun; ++u) {
        const int bh = AT_UBH(u), j = AT_UJ(u), b = bh >> 3, h = bh & 7, hcol = h * HD;
        const size_t qrow0 = (size_t)b * SEQ + (size_t)j * 256;
        const int kmo = O_KM + ((u >> 1) & 1) * 4096;
        if ((u & 1) == 0) {
            ((LAS float*)(L + kmo))[tid] = kms[0]; ((LAS float*)(L + kmo))[tid + 512] = kms[1];
            asm volatile("s_waitcnt lgkmcnt(0)" ::: "memory");
            AT_SBAR(); __builtin_amdgcn_s_barrier(); AT_SBAR();
        }
        const int qrel = 32 * wid + r32;
        const int NT = 4 * (j + 1);
        float m_reg = 0.f, l_reg = 0.f; f32x16 o[4];
#pragma unroll
        for (int d = 0; d < 4; ++d)
#pragma unroll
            for (int r = 0; r < 16; ++r) o[d][r] = 0.f;
        f32x16 pA0, pA1, pB0, pB1; float alA, alB; bf16x8 pa0, pa1, pa2, pa3; u32x2 qm = (u32x2){0u, 0u}; const unsigned negpk = hi ? 0u : 0x0000FF80u;
        unsigned mk = 0u;
        {
            float gt[7]; f32x4 qa[8], qb[8];
#pragma unroll
            for (int d0 = 0; d0 < 8; ++d0) { const u32x4 q = __builtin_bit_cast(u32x4, qr[d0]); qa[d0] = (f32x4){bflo(q.x), bfhi(q.x), bflo(q.y), bfhi(q.y)}; qb[d0] = (f32x4){bflo(q.z), bfhi(q.z), bflo(q.w), bfhi(q.w)}; }
#pragma unroll
            for (int nb = 0; nb < 7; ++nb) { float s_ = NEG_INF;
                if (nb < j) { s_ = 0.f; const LAS f32x4* kp = (const LAS f32x4*)(L + kmo + (nb * 128 + hi * 8) * 4);
#pragma unroll
                    for (int d0 = 0; d0 < 8; ++d0) { const f32x4 k0 = kp[4 * d0], k1 = kp[4 * d0 + 1];
                        s_ += (qa[d0][0] * k0[0] + qa[d0][1] * k0[1]) + (qa[d0][2] * k0[2] + qa[d0][3] * k0[3]) + (qb[d0][0] * k1[0] + qb[d0][1] * k1[1]) + (qb[d0][2] * k1[2] + qb[d0][3] * k1[3]); }
                    s_ += __shfl_xor(s_, 32); }
                gt[nb] = s_; }
#pragma unroll
            for (int nb = 0; nb < 7; ++nb) { int cnt = 0;
#pragma unroll
                for (int mb = 0; mb < 7; ++mb) if (mb != nb) cnt += ((gt[mb] > gt[nb]) || (gt[mb] == gt[nb] && mb < nb)) ? 1 : 0;
                if (nb < j && cnt < 3) mk |= 1u << nb; }
        }
        AT_BAR(8);
        qkt(pA0, pA1, L + O_K, kb, qr, qm); partialSM<true>(pA0, pA1, m_reg, alA, qm, (wid >> 1) == 0, qrel - 4 * hi, hi);
        AT_SBAR(); AT_DMA(2 * SHM_K, bh, j, 2); AT_SBAR();
#define AT_STEP(PN0, PN1, KS, ALN, PO0, PO1, ALO, VS, TN, LOADSTMT) do { \
        if constexpr (LEAD) { AT_SBAR(); qkt(PN0, PN1, L + O_K + (KS), kb, qr, AT_QME(TN)); AT_SBAR(); finishSM(PO0, PO1, ALO, l_reg, pa0, pa1, pa2, pa3); AT_SBAR(); LOADSTMT; AT_SBAR(); \
                    pv_d0(o, vb0 + (VS), pa0, pa1, pa2, pa3); AT_SBAR(); AT_PSM(PN0, PN1, ALN, TN); AT_SBAR(); } \
        else                { AT_SBAR(); finishSM(PO0, PO1, ALO, l_reg, pa0, pa1, pa2, pa3); AT_SBAR(); qkt(PN0, PN1, L + O_K + (KS), kb, qr, AT_QME(TN)); AT_SBAR(); LOADSTMT; AT_SBAR(); \
                    AT_PSM(PN0, PN1, ALN, TN); AT_SBAR(); pv_d0(o, vb0 + (VS), pa0, pa1, pa2, pa3); AT_SBAR(); } } while (0)
        int kofs = 0;
        for (int n = 1; n + 1 < NT; n += 2) {
            AT_STEP(pB0, pB1, SHM_K + kofs, alB, pA0, pA1, alA, kofs, n, AT_DMA(3 * SHM_K - kofs, bh, j, n + 2));
            AT_RESC(alB); AT_BAR(4);
            const bool more = n + 3 < NT;
            AT_STEP(pA0, pA1, 2 * SHM_K - kofs, alA, pB0, pB1, alB, SHM_V + kofs, n + 1, if (more) AT_DMA(kofs, bh, j, n + 3));
            AT_RESC(alA); if (more) AT_BAR(4); else AT_BAR(0);
            kofs ^= 2 * SHM_K;
        }
        AT_STEP(pB0, pB1, 3 * SHM_K, alB, pA0, pA1, alA, 2 * SHM_V, NT - 1, if (u + 1 < nun) AT_UNIT_REQ(u + 1));
        AT_SBAR(); __builtin_amdgcn_s_barrier(); AT_SBAR();
        int ln2_ = lane; asm volatile("" : "+v"(ln2_));
        const bf16* zs_u = ZS + qrow0 * DM + hcol; bf16* a1_u = A1 + qrow0 * DM + hcol;
        const unsigned ro0 = (unsigned)((32 * wid + (ln2_ >> 4)) * DM + (ln2_ & 15) * 8); const int so_ = (ln2_ >> 4) * 256 + (ln2_ & 15) * 16;
        float kma[2] = {0.f, 0.f}, kmb[2] = {0.f, 0.f};
        if ((u & 1) && u + 1 < nun) AT_KM_REQ(u + 1);
        u32x4 zz[8];
#pragma unroll
        for (int i = 0; i < 8; ++i) zz[i] = *(const GAS u32x4*)(zs_u + (ro0 + i * 4 * DM));
        AT_SBAR();
        AT_RESC(alB);
        finishSM(pB0, pB1, alB, l_reg, pa0, pa1, pa2, pa3); AT_SBAR();
        pv_d0(o, vb0 + 3 * SHM_V, pa0, pa1, pa2, pa3);
#undef AT_STEP
        if (hi == 0) li_l[r32] = l_reg; asm volatile("s_waitcnt lgkmcnt(0)" ::: "memory");
        {
            LAS unsigned char* st = L + O_OST + wid * 4096;
            LAS unsigned char* stw = st + (ln2_ >> 5) * 1024 + (ln2_ & 31) * 2;
            const LAS float* lil = li_l + 4 * (ln2_ >> 5);
#pragma unroll
            for (int ps = 0; ps < 2; ++ps) {
#pragma unroll
                for (int r8 = 0; r8 < 8; ++r8) { const int r = 8 * ps + r8, ro_ = (r8 & 3) + 8 * (r8 >> 2); const float rl = __builtin_amdgcn_rcpf(lil[(r & 3) + 8 * (r >> 2)]);
#pragma unroll
                    for (int d0 = 0; d0 < 4; ++d0) *(LAS bf16*)(stw + ro_ * 256 + d0 * 64) = f2bf(o[d0][r] * rl); }
#pragma unroll
                for (int ii = 0; ii < 4; ++ii) { const int i = 4 * ps + ii; const u32x4 z = zz[i]; const u32x4 ov = *(const LAS u32x4*)(st + so_ + ii * 1024);
                    u32x4 w_; w_.x = pk2(bflo(ov.x) * bflo(z.x), bfhi(ov.x) * bfhi(z.x)); w_.y = pk2(bflo(ov.y) * bflo(z.y), bfhi(ov.y) * bfhi(z.y));
                    w_.z = pk2(bflo(ov.z) * bflo(z.z), bfhi(ov.z) * bfhi(z.z)); w_.w = pk2(bflo(ov.w) * bflo(z.w), bfhi(ov.w) * bfhi(z.w));
                    *(GAS u32x4*)(a1_u + (ro0 + i * 4 * DM)) = w_; }
            }
        }
        if (u & 1) { kms[0] = kma[0] + kmb[0]; kms[1] = kma[1] + kmb[1]; }
    }
    asm volatile("s_waitcnt vmcnt(0)" ::: "memory");
    __syncthreads();
#undef AT_UBH
#undef AT_UJ
#undef AT_KROW
#undef AT_DMA
#undef AT_BAR
#undef AT_RESC
#undef AT_PSM
#undef AT_QME
#undef AT_UNIT_REQ
#undef AT_KM_REQ
}
__device__ __forceinline__ void p7_attention2(Frame& F) { if (F.wave < 4) p7_body<true>(F); else p7_body<false>(F); }

struct Args { const void* in[15]; float* out; unsigned char* ws; int ph_lo, ph_hi; };
__global__ void __launch_bounds__(NWAVES * 64, 2) fwd(Args args) {
    extern __shared__ __attribute__((aligned(16))) unsigned char lds[];
    Frame F;
    F.lds = (LAS unsigned char*)lds;
    F.tid = threadIdx.x; F.lane = F.tid & 63; F.wave = __builtin_amdgcn_readfirstlane(F.tid >> 6);
    F.G = gridDim.x; { const int bx = blockIdx.x; F.vcu = (F.G % 8 == 0) ? (bx % 8) * (F.G / 8) + bx / 8 : bx; }
    unsigned char* ws = args.ws;
    F.x = (const float*)args.in[0]; F.c = (const float*)args.in[1]; F.pos = (const int*)args.in[2]; F.mod_w = (const float*)args.in[3]; F.mod_b = (const float*)args.in[4];
    F.pre_g = (const float*)args.in[5]; F.post_g = (const float*)args.in[6]; F.a_w_in = (const float*)args.in[7]; F.a_w_out = (const float*)args.in[8]; F.a_gn = (const float*)args.in[9];
    F.a_lb = (const float*)args.in[10]; F.kv_g = (const float*)args.in[11]; F.w_kv = (const float*)args.in[12]; F.b_w_in = (const float*)args.in[13]; F.b_w_out = (const float*)args.in[14];
    F.out = args.out;
    F.Win0 = (bf16*)(ws + WS_WIN0); F.Wout0 = (bf16*)(ws + WS_WOUT0); F.Wkv = (bf16*)(ws + WS_WKV); F.Win1 = (bf16*)(ws + WS_WIN1); F.Wout1 = (bf16*)(ws + WS_WOUT1);
    F.MOD = (float*)(ws + WS_MOD); F.LB = (float*)(ws + WS_LB); F.TAB = (float*)(ws + WS_TAB); F.KM = (float*)(ws + WS_KM);
    F.S0 = (bf16*)(ws + WS_S0); F.S1 = (bf16*)(ws + WS_S1); F.S2 = (bf16*)(ws + WS_S2); F.S3 = (bf16*)(ws + WS_S3); F.S4 = (bf16*)(ws + WS_S4); F.S5 = (bf16*)(ws + WS_S5); F.S6 = (bf16*)(ws + WS_S6);
    volatile LAS unsigned* MISC = (volatile LAS unsigned*)(F.lds + MISC_OFF);
    for (int u = F.tid; u < (LDS_BYTES - LDSCTL_OFF) / 4; u += NWAVES * 64) ((LAS unsigned*)(F.lds + LDSCTL_OFF))[u] = 0u;
    __syncthreads();
    XcdBarrier bar; bar.bar = (unsigned*)(ws + WS_CTL) + CW_BAR; bar.x = 0; bar.st = nullptr;
    if (N_LAUNCHES == 1) bar = xcd_barrier_post((unsigned*)(ws + WS_CTL) + CW_BAR, MISC + 8);
    const int lo = args.ph_lo, hi = args.ph_hi;
#define IN(k) (lo <= (k) && (k) < hi)
#define SEAM(k) do { if (IN(k) && IN((k) + 1)) xcd_barrier(bar); } while (0)
#define WGSEAM(k) do { if (IN(k) && IN((k) + 1)) { asm volatile("s_waitcnt vmcnt(0)" ::: "memory"); __syncthreads(); } } while (0)

    if (IN(0)) { p0_prologue(F); } SEAM(0);
    if (IN(1)) { p1_modnorm(F); } SEAM(1);
    if (IN(2)) {
        pg8::Gemm g{F.S0, F.Win0, M, 4096, DM}; pg8::StaticOrder S; S.init(M, 4096, F.G, (int)blockIdx.x);
        pg8::EpiL0 E{F.S1, F.S2, F.S3, F.S4, F.LB};
        pg8::gemm_phase<pg8::EpiL0, pg8::StaticOrder, true, true>(F.lds, g, S, E);
    } SEAM(2);
    if (IN(3)) { p3_recurrence3(F); } SEAM(3);
    if (IN(4)) {
        pg8::Gemm g{F.S5, F.Wout0, M, DM, DM}; pg8::PanelOrder S; S.init(M, DM, F.G, F.vcu);
        pg8::EpiBf16<0> E{F.S6, DM, nullptr, 0, 0, 1.f};
        pg8::gemm_phase<pg8::EpiBf16<0>, pg8::PanelOrder, true, true>(F.lds, g, S, E);
    } WGSEAM(4);
    if (IN(5)) { p5_mid(F); } SEAM(5);
    if (IN(6)) {
        { pg8::Gemm g{F.S1, F.Wkv, M, 2048, DM}; pg8::StaticOrder S; S.init(M, 2048, F.G, (int)blockIdx.x);
          pg8::EpiKV E{F.S2, F.S3, F.pos, F.TAB, F.KM};
          pg8::gemm_phase<pg8::EpiKV, pg8::StaticOrder, true, true>(F.lds, g, S, E); }
        { pg8::Gemm g{F.S0, F.Win1, M, 2048, DM}; pg8::StaticOrder S; S.init(M, 2048, F.G, (int)blockIdx.x);
          pg8::EpiQZ E{F.S4, F.S5, F.pos, F.TAB, QSCALE};
          pg8::gemm_phase<pg8::EpiQZ, pg8::StaticOrder, true, true>(F.lds, g, S, E); }
    } SEAM(6);
    if (IN(7)) { p7_attention2(F); } SEAM(7);
    if (IN(8)) {
        pg8::Gemm g{F.S6, F.Wout1, M, DM, DM}; pg8::PanelOrder S; S.init(M, DM, F.G, F.vcu);
        pg8::EpiBf16<0> E{F.S0, DM, nullptr, 0, 0, 1.f};
        pg8::gemm_phase<pg8::EpiBf16<0>, pg8::PanelOrder, true, true>(F.lds, g, S, E);
    } WGSEAM(8);
    if (IN(9)) { p9_final(F); }
#undef IN
#undef SEAM
#undef WGSEAM
}

extern "C" void kernel_launch(void* const* d_in, const int* in_sizes, int n_in, void* d_out, int out_size, void* d_ws, size_t ws_size, hipStream_t stream) {
    static int grid = 0;
    if (grid == 0) {
        if (n_in != 15 || in_sizes[0] != M * DM || out_size != M * DM || ws_size < WS_END) { fprintf(stderr, "kernel_launch: unexpected shapes (n_in %d, in0 %d, out %d, ws %zu); nothing launched\n", n_in, n_in > 0 ? in_sizes[0] : -1, out_size, ws_size); grid = -1; return; }
        int dev = 0, cus = 0, per_cu = 0;
        if (hipGetDevice(&dev) != hipSuccess || hipDeviceGetAttribute(&cus, hipDeviceAttributeMultiprocessorCount, dev) != hipSuccess) { grid = -1; return; }
        if (hipFuncSetAttribute((const void*)fwd, hipFuncAttributeMaxDynamicSharedMemorySize, LDS_BYTES) != hipSuccess) { fprintf(stderr, "kernel_launch: hipFuncSetAttribute failed\n"); grid = -1; return; }
        if (hipOccupancyMaxActiveBlocksPerMultiprocessor(&per_cu, (const void*)fwd, NWAVES * 64, LDS_BYTES) != hipSuccess || per_cu < 1) { fprintf(stderr, "kernel_launch: occupancy query says %d blocks per CU\n", per_cu); }
        (void)hipGetLastError();
        grid = cus;
    }
    if (grid < 0) return;
    static_assert((size_t)(CW_BAR + XCD_BAR_WORDS) * 4 <= CTL_ZERO_BYTES, "the zeroed control region must cover the barrier words");
    if (hipMemsetAsync((char*)d_ws + WS_CTL, 0, CTL_ZERO_BYTES, stream) != hipSuccess) { fprintf(stderr, "kernel_launch: memset failed\n"); return; }
    Args a{};
    for (int i = 0; i < 15; ++i) a.in[i] = d_in[i];
    a.out = (float*)d_out; a.ws = (unsigned char*)d_ws;
    for (int li = 0; li < N_LAUNCHES; ++li) {
        a.ph_lo = (N_LAUNCHES == 1) ? 0 : li; a.ph_hi = (N_LAUNCHES == 1) ? NPH : li + 1;
        hipLaunchKernelGGL(fwd, dim3(grid), dim3(NWAVES * 64), LDS_BYTES, stream, a);
        const hipError_t le = hipPeekAtLastError();
        if (le != hipSuccess) { fprintf(stderr, "kernel_launch: launch %d failed: %s\n", li, hipGetErrorName(le)); break; }
    }
}
```
